# Optimizing an MI355X kernel written in HIP

```python
import jax, jax.numpy as jnp
from jax import lax
import numpy as np

D_MODEL = 2048
BATCH = 4
SEQ = 8192
DEPTH = 4
DEC_BATCH = 4
DEC_SEQ = 2048
PAST_LEN = 128

HEAD_DIM = 128
BLOCK = 128
GRID_W = 64
EPS = 1e-6
A_WIDTH = D_MODEL // 2
A_GROUPS = A_WIDTH // HEAD_DIM
A_CHUNK = 128
B_WIDTH = D_MODEL // 2
B_HEADS = B_WIDTH // HEAD_DIM
B_KV_HEADS = 2
B_WINDOW = 128
ROPE_THETA = 500000.0
ROPE_DIMS = HEAD_DIM // 4
C_WIDTH = D_MODEL
C_HEADS = C_WIDTH // HEAD_DIM
C_KV_HEADS = 4
AXIAL_THETA = 10000.0
N_EVEN = (DEPTH + 1) // 2
N_ODD = DEPTH // 2
AB_IN = 3 * A_WIDTH + 2 * B_WIDTH + 2 * B_KV_HEADS * HEAD_DIM
C_IN = 2 * C_WIDTH + 2 * C_KV_HEADS * HEAD_DIM

kernel_name = "hybrid_gmlp_window_axial_encoder"


def _split_points(sizes):
    pts, acc = [], 0
    for s in sizes[:-1]:
        acc += s
        pts.append(acc)
    return pts


def rms_norm(x, g):
    xf = x.astype(jnp.float32)
    y = xf * lax.rsqrt(jnp.mean(xf * xf, axis=-1, keepdims=True) + EPS)
    return (y * g.astype(jnp.float32)).astype(x.dtype)


def rope(x, pos, theta):
    d = x.shape[-1]
    inv = jnp.power(jnp.float32(theta), -jnp.arange(d // 2, dtype=jnp.float32) * (2.0 / d))
    ang = pos[:, None] * inv[None, :]
    cos = jnp.cos(ang)[:, None, :]
    sin = jnp.sin(ang)[:, None, :]
    xf = x.astype(jnp.float32)
    x1, x2 = xf[..., : d // 2], xf[..., d // 2:]
    out = jnp.concatenate([x1 * cos - x2 * sin, x2 * cos + x1 * sin], axis=-1)
    return out.astype(x.dtype)


def partial_rope(x, pos):
    return jnp.concatenate([rope(x[..., :ROPE_DIMS], pos, ROPE_THETA), x[..., ROPE_DIMS:]], axis=-1)


def axial_rope(x, row, col):
    half = x.shape[-1] // 2
    return jnp.concatenate([rope(x[..., :half], row, AXIAL_THETA), rope(x[..., half:], col, AXIAL_THETA)], axis=-1)


def mixer_a(u, v, v_norm, w_s, b_s):
    bn, s, _ = v.shape
    nc = s // A_CHUNK
    vn = rms_norm(v.reshape(bn, s, A_GROUPS, HEAD_DIM), v_norm.reshape(A_GROUPS, HEAD_DIM))
    vc = vn.reshape(bn, nc, A_CHUNK, A_GROUPS, HEAD_DIM)
    mixed = jnp.einsum('gpq,bcqgd->bcpgd', w_s, vc) + b_s.T[None, None, :, :, None]
    return u * mixed.reshape(bn, s, A_WIDTH)


def mixer_b(q, k, v, q_norm, k_norm, sink, pos):
    bn, s, _ = q.shape
    nb = s // BLOCK
    rep = B_HEADS // B_KV_HEADS
    q = partial_rope(rms_norm(q.reshape(bn, s, B_HEADS, HEAD_DIM), q_norm), pos)
    k = partial_rope(rms_norm(k.reshape(bn, s, B_KV_HEADS, HEAD_DIM), k_norm), pos)
    v = v.reshape(bn, s, B_KV_HEADS, HEAD_DIM)
    qb = q.reshape(bn, nb, BLOCK, B_KV_HEADS, rep, HEAD_DIM)
    pad = ((0, 0), (BLOCK, BLOCK), (0, 0), (0, 0))
    kp = jnp.pad(k, pad)
    vp = jnp.pad(v, pad)
    idx = jnp.arange(nb)[:, None] * BLOCK + jnp.arange(3 * BLOCK)[None, :]
    kb = kp[:, idx]
    vb = vp[:, idx]
    scale = HEAD_DIM ** -0.5
    sc = jnp.einsum('bnqhrd,bnkhd->bnhrqk', qb, kb).astype(jnp.float32) * scale
    qpos = jnp.arange(nb)[:, None] * BLOCK + jnp.arange(BLOCK)[None, :]
    kpos = idx - BLOCK
    mask = (jnp.abs(qpos[:, :, None] - kpos[:, None, :]) <= B_WINDOW) & (kpos[:, None, :] >= 0) & (kpos[:, None, :] < s)
    sc = jnp.where(mask[None, :, None, None, :, :], sc, jnp.float32(-1e30))
    sink_l = jnp.broadcast_to(sink.astype(jnp.float32).reshape(B_KV_HEADS, rep)[None, None, :, :, None, None],
                              sc.shape[:-1] + (1,))
    p = jax.nn.softmax(jnp.concatenate([sc, sink_l], axis=-1), axis=-1)[..., :-1]
    o = jnp.einsum('bnhrqk,bnkhd->bnqhrd', p.astype(vb.dtype), vb)
    return o.reshape(bn, s, B_WIDTH)


def mixer_c(q, k, v, q_norm, k_norm, row, col):
    bn, s, _ = q.shape
    nb = s // BLOCK
    rep = C_HEADS // C_KV_HEADS
    q = axial_rope(rms_norm(q.reshape(bn, s, C_HEADS, HEAD_DIM), q_norm), row, col)
    k = axial_rope(rms_norm(k.reshape(bn, s, C_KV_HEADS, HEAD_DIM), k_norm), row, col)
    v = v.reshape(bn, s, C_KV_HEADS, HEAD_DIM)
    qb = q.reshape(bn, nb, BLOCK, C_KV_HEADS, rep, HEAD_DIM).transpose(1, 0, 2, 3, 4, 5)
    scale = HEAD_DIM ** -0.5

    def attend(qblk):
        sc = jnp.einsum('bqhrd,bkhd->bhrqk', qblk, k).astype(jnp.float32) * scale
        p = jax.nn.softmax(sc, axis=-1).astype(v.dtype)
        return jnp.einsum('bhrqk,bkhd->bqhrd', p, v)

    o = lax.map(attend, qb)
    return o.transpose(1, 0, 2, 3, 4, 5).reshape(bn, s, C_WIDTH)


def even_layer(x, norm_g, w_in, w_out, a_vn, a_ws, a_bs, b_qn, b_kn, b_sink, pos):
    h = rms_norm(x, norm_g)
    z = h @ w_in
    sizes = [A_WIDTH, A_WIDTH, A_WIDTH, B_WIDTH, B_KV_HEADS * HEAD_DIM, B_KV_HEADS * HEAD_DIM, B_WIDTH]
    a_u, a_v, a_g, b_q, b_k, b_v, b_g = jnp.split(z, _split_points(sizes), axis=-1)
    ya = mixer_a(jax.nn.gelu(a_u), jax.nn.gelu(a_v), a_vn, a_ws, a_bs) * jax.nn.silu(a_g)
    yb = mixer_b(b_q, b_k, b_v, b_qn, b_kn, b_sink, pos) * jax.nn.silu(b_g)
    return x + jnp.concatenate([ya, yb], axis=-1) @ w_out


def odd_layer(x, norm_g, w_in, w_out, c_qn, c_kn, row, col):
    h = rms_norm(x, norm_g)
    z = h @ w_in
    sizes = [C_WIDTH, C_KV_HEADS * HEAD_DIM, C_KV_HEADS * HEAD_DIM, C_WIDTH]
    c_q, c_k, c_v, c_g = jnp.split(z, _split_points(sizes), axis=-1)
    yc = mixer_c(c_q, c_k, c_v, c_qn, c_kn, row, col) * jax.nn.silu(c_g)
    return x + yc @ w_out


def trunk(x, norm_ab, w_in_ab, w_out_ab, a_v_norm, a_w_s, a_b_s, b_q_norm, b_k_norm, b_sink,
          norm_c, w_in_c, w_out_c, c_q_norm, c_k_norm):
    s = x.shape[1]
    rows = s // GRID_W
    pos = jnp.arange(s, dtype=jnp.float32)
    rr, cc = jnp.meshgrid(jnp.arange(rows, dtype=jnp.float32), jnp.arange(GRID_W, dtype=jnp.float32), indexing='ij')
    row, col = rr.reshape(-1), cc.reshape(-1)
    for layer in range(DEPTH):
        i = layer // 2
        if layer % 2 == 0:
            x = even_layer(x, norm_ab[i], w_in_ab[i], w_out_ab[i], a_v_norm[i], a_w_s[i], a_b_s[i],
                           b_q_norm[i], b_k_norm[i], b_sink[i], pos)
        else:
            x = odd_layer(x, norm_c[i], w_in_c[i], w_out_c[i], c_q_norm[i], c_k_norm[i], row, col)
    return x


def setup_inputs(seed: int = 0) -> dict:
    key = jax.random.key(seed)
    ks = jax.random.split(key, 20)
    f32 = jnp.float32
    nrm = lambda k, shape, sc: jax.random.normal(k, shape, f32) * sc
    gain = lambda k, shape: 1.0 + 0.02 * jax.random.normal(k, shape, f32)
    return {
        "x_prompt": jax.random.normal(ks[0], (BATCH, SEQ, D_MODEL), f32),
        "x_sample": jax.random.normal(ks[1], (DEC_BATCH, DEC_SEQ, D_MODEL), f32),
        "norm_ab": gain(ks[2], (N_EVEN, D_MODEL)),
        "w_in_ab": nrm(ks[3], (N_EVEN, D_MODEL, AB_IN), D_MODEL ** -0.5),
        "w_out_ab": nrm(ks[4], (N_EVEN, A_WIDTH + B_WIDTH, D_MODEL), 0.5 * (A_WIDTH + B_WIDTH) ** -0.5),
        "a_v_norm": gain(ks[5], (N_EVEN, A_WIDTH)),
        "a_w_s": nrm(ks[6], (N_EVEN, A_GROUPS, A_CHUNK, A_CHUNK), 0.5 * A_CHUNK ** -0.5),
        "a_b_s": 1.0 + nrm(ks[7], (N_EVEN, A_GROUPS, A_CHUNK), 0.01),
        "b_q_norm": gain(ks[8], (N_EVEN, HEAD_DIM)),
        "b_k_norm": gain(ks[9], (N_EVEN, HEAD_DIM)),
        "b_sink": nrm(ks[10], (N_EVEN, B_HEADS), 0.5),
        "norm_c": gain(ks[11], (N_ODD, D_MODEL)),
        "w_in_c": nrm(ks[12], (N_ODD, D_MODEL, C_IN), D_MODEL ** -0.5),
        "w_out_c": nrm(ks[13], (N_ODD, C_WIDTH, D_MODEL), 0.5 * C_WIDTH ** -0.5),
        "c_q_norm": gain(ks[14], (N_ODD, HEAD_DIM)),
        "c_k_norm": gain(ks[15], (N_ODD, HEAD_DIM)),
    }


def reference(x_prompt, x_sample, norm_ab, w_in_ab, w_out_ab, a_v_norm, a_w_s, a_b_s, b_q_norm, b_k_norm,
              b_sink, norm_c, w_in_c, w_out_c, c_q_norm, c_k_norm):
    y_prompt = trunk(x_prompt, norm_ab, w_in_ab, w_out_ab, a_v_norm, a_w_s, a_b_s, b_q_norm, b_k_norm, b_sink,
                     norm_c, w_in_c, w_out_c, c_q_norm, c_k_norm)
    y_sample = trunk(x_sample, norm_ab, w_in_ab, w_out_ab, a_v_norm, a_w_s, a_b_s, b_q_norm, b_k_norm, b_sink,
                     norm_c, w_in_c, w_out_c, c_q_norm, c_k_norm)
    return (y_prompt, y_sample)
```

```cpp
#include <hip/hip_runtime.h>
#include <hip/hip_cooperative_groups.h>
#include <cstdio>
#include <cstdint>
namespace cg = cooperative_groups;

#define LAS __attribute__((address_space(3)))
typedef unsigned short u16;
typedef _Float16 hx8 __attribute__((ext_vector_type(8)));
typedef _Float16 hx4 __attribute__((ext_vector_type(4)));
typedef _Float16 hx2 __attribute__((ext_vector_type(2)));
typedef short s16x4 __attribute__((ext_vector_type(4)));
typedef short s16x8 __attribute__((ext_vector_type(8)));
typedef float f32x2 __attribute__((ext_vector_type(2)));
typedef float f32x4 __attribute__((ext_vector_type(4)));
typedef float f32x16 __attribute__((ext_vector_type(16)));
typedef unsigned u32x2 __attribute__((ext_vector_type(2)));
typedef unsigned u32x4 __attribute__((ext_vector_type(4)));

constexpr int DM = 2048, SEQ_P = 8192, SEQ_S = 2048, NTOK_P = 4 * SEQ_P, NTOK_S = 4 * SEQ_S, MTOK = NTOK_P + NTOK_S;
constexpr int AB_IN = 5632, C_IN = 5120;
constexpr float EPS = 1e-6f;
#ifndef MK_MULTI
#define MK_MULTI 0
#endif

__device__ __forceinline__ unsigned pkh(float lo, float hi) { hx2 v = {(_Float16)lo, (_Float16)hi}; return __builtin_bit_cast(unsigned, v); }
__device__ __forceinline__ float h2f(u16 b) { return (float)__builtin_bit_cast(_Float16, b); }
__device__ __forceinline__ u16 f2h(float f) { return __builtin_bit_cast(u16, (_Float16)f); }
__device__ __forceinline__ float wave_sum(float v) {
#pragma unroll
    for (int o = 1; o < 64; o <<= 1) v += __shfl_xor(v, o);
    return v;
}
__device__ __forceinline__ float sigmoidf_fast(float t) { return __builtin_amdgcn_rcpf(1.0f + __expf(-t)); }
__device__ __forceinline__ float gelu_tanh(float v) { const float u = 0.7978845608028654f * (v + 0.044715f * v * v * v); return v * sigmoidf_fast(2.0f * u); }
__device__ __forceinline__ float silu_f(float v) { return v * sigmoidf_fast(v); }
__device__ __forceinline__ f32x2 act_tail2(f32x2 v, f32x2 a) { f32x2 ex; ex.x = __builtin_amdgcn_exp2f(a.x); ex.y = __builtin_amdgcn_exp2f(a.y); const f32x2 d = ex + 1.0f; f32x2 r; r.x = __builtin_amdgcn_rcpf(d.x); r.y = __builtin_amdgcn_rcpf(d.y); return v * r; }
__device__ __forceinline__ f32x2 gelu2(f32x2 v) { const f32x2 p = (v * v) * (-0.10294323970f) + (-2.30220819813f); return act_tail2(v, v * p); }
__device__ __forceinline__ f32x2 silu2(f32x2 v) { return act_tail2(v, v * (-1.4426950408889634f)); }
__device__ __forceinline__ f32x4 gelu4(f32x4 v) { const f32x2 a = gelu2((f32x2){v[0], v[1]}), b = gelu2((f32x2){v[2], v[3]}); return (f32x4){a.x, a.y, b.x, b.y}; }
__device__ __forceinline__ f32x4 silu4(f32x4 v) { const f32x2 a = silu2((f32x2){v[0], v[1]}), b = silu2((f32x2){v[2], v[3]}); return (f32x4){a.x, a.y, b.x, b.y}; }

namespace pg8 {
#define PG8_LAS __attribute__((address_space(3)))
typedef unsigned short bf16_t;
typedef _Float16 bf16x8 __attribute__((ext_vector_type(8)));
typedef float f32x4 __attribute__((ext_vector_type(4)));
typedef unsigned u32x4 __attribute__((ext_vector_type(4)));
constexpr int BM = 256, BK = 64, HALF = 128, HTB = HALF * BK * 2  , STAGE_BYTES = 8 * HTB, NXCD = 8, WGM = 4;

__host__ __device__ __forceinline__ int lds_byte(int r, int c) { const int st = (r >> 4) * 2 + (c >> 5), rr = r & 15, cc = c & 31, ob = rr * 64 + cc * 2; return st * 1024 + (ob ^ (((ob >> 9) & 1) << 5)); }
__host__ __device__ __forceinline__ void stage_rc(int b, int& R, int& C) { const int st = b / 1024, sb = b % 1024, swz = sb ^ (((sb >> 9) & 1) << 5); R = (st >> 1) * 16 + swz / 64; C = (st & 1) * 32 + (swz % 64) / 2; }
__host__ __device__ __forceinline__ int perm32(int rho) { const int n = rho >> 4, i = rho & 15; return 8 * (i >> 2) + 4 * n + (i & 3); }

struct Unit { int pm, pn, idx; };
struct Gemm { const bf16_t* A; const bf16_t* Bt; int M, N, K; };

struct StaticOrder {
    int nM, nN, nwg, G, c;
    __host__ __device__ void init(int M, int N, int G_, int c_) { nM = M / BM; nN = N / BM; nwg = nM * nN; G = G_; c = c_; }
    __host__ __device__ bool next(int i, Unit& u) const {
        const long L = (long)i * G + c; if (L >= nwg) return false;
        int wgid = (int)L; { const int q = nwg / NXCD, r = nwg % NXCD, xcd = wgid % NXCD, off = wgid / NXCD; wgid = (xcd < r ? xcd * (q + 1) : r * (q + 1) + (xcd - r) * q) + off; }
        const int nig = WGM * nN, gid = wgid / nig, fm = gid * WGM, gsz = (nM - fm) < WGM ? (nM - fm) : WGM;
        u.pm = fm + ((wgid % nig) % gsz); u.pn = (wgid % nig) / gsz; u.idx = i; return true;
    }
    __device__ __forceinline__ void a_ready(const Unit&) const {}
    __device__ __forceinline__ void done(const Unit&) const {}
};

struct EpiAct {
    static constexpr bool PERM = true, AFTER_DRAIN = false;
    u16* O; int ldc; int g_end, s_end, n_end; u16* KV; int kv_lo, kv_hi; const LAS float* rst;
    template <int ACT> __device__ __forceinline__ void run(const f32x4 (&acc)[2][2][4][2], const Unit& u, int wr, int wc, int fr, int fq) const {
        const int row0 = u.pm * BM + wr * 64 + fr, col0 = u.pn * BM + wc * 32 + 8 * fq;
#pragma unroll
        for (int ai = 0; ai < 2; ++ai)
#pragma unroll
            for (int m = 0; m < 4; ++m) { u16* rowp = O + (size_t)(row0 + ai * HALF + m * 16) * ldc + col0;
                const float rs = rst[u.idx * 256 + wr * 64 + fr + ai * HALF + m * 16];
#pragma unroll
                for (int bj = 0; bj < 2; ++bj) { f32x4 v0 = acc[ai][bj][m][0] * rs, v1 = acc[ai][bj][m][1] * rs;
                    if (ACT == 1) { v0 = gelu4(v0); v1 = gelu4(v1); }
                    if (ACT == 2) { v0 = silu4(v0); v1 = silu4(v1); }
                    u32x4 w; w.x = pkh(v0[0], v0[1]); w.y = pkh(v0[2], v0[3]); w.z = pkh(v1[0], v1[1]); w.w = pkh(v1[2], v1[3]);
                    __builtin_nontemporal_store(w, (u32x4*)(rowp + bj * HALF)); } }
    }
    __device__ __forceinline__ void run_kv(const f32x4 (&acc)[2][2][4][2], const Unit& u, int wr, int wc, int fr, int fq) const {
        const int row0 = u.pm * BM + wr * 64 + fr, slot0 = (u.pn * BM - kv_lo) >> 7;
#pragma unroll
        for (int ai = 0; ai < 2; ++ai)
#pragma unroll
            for (int m = 0; m < 4; ++m) { const float rs = rst[u.idx * 256 + wr * 64 + fr + ai * HALF + m * 16];
#pragma unroll
                for (int bj = 0; bj < 2; ++bj) { const f32x4 v0 = acc[ai][bj][m][0] * rs, v1 = acc[ai][bj][m][1] * rs;
                    u32x4 w; w.x = pkh(v0[0], v0[1]); w.y = pkh(v0[2], v0[3]); w.z = pkh(v1[0], v1[1]); w.w = pkh(v1[2], v1[3]);
                    *(u32x4*)(KV + ((size_t)(slot0 + bj) * MTOK + (row0 + ai * HALF + m * 16)) * 128 + wc * 32 + 8 * fq) = w; } }
    }
    __device__ __forceinline__ void operator()(const f32x4 (&acc)[2][2][4][2], const Unit& u, int wr, int wc, int fr, int fq) const {
        const int colt = u.pn * BM; if (colt >= kv_lo && colt < kv_hi) { run_kv(acc, u, wr, wc, fr, fq); return; }
        const int act = colt < g_end ? 1 : (colt < s_end ? 2 : (colt < n_end ? 0 : 2));
        if (act == 1) run<1>(acc, u, wr, wc, fr, fq); else if (act == 2) run<2>(acc, u, wr, wc, fr, fq); else run<0>(acc, u, wr, wc, fr, fq);
    }
};
struct EpiRes {
    static constexpr bool PERM = true, AFTER_DRAIN = false;
    const float* base0; const float* base1; const u16* Hb; float* out; int ldc; int split_row; u16* Hn; float* ssqn;
    __device__ __forceinline__ void operator()(const f32x4 (&acc)[2][2][4][2], const Unit& u, int wr, int wc, int fr, int fq) const {
        const int row0 = u.pm * BM + wr * 64 + fr, col0 = u.pn * BM + wc * 32 + 8 * fq;
        const float* base = (u.pm * BM < split_row) ? base0 : base1;
#pragma unroll
        for (int ai = 0; ai < 2; ++ai)
#pragma unroll
            for (int m = 0; m < 4; ++m) { const size_t off = (size_t)(row0 + ai * HALF + m * 16) * ldc + col0; float s = 0.f;
#pragma unroll
                for (int bj = 0; bj < 2; ++bj) { f32x4 b0, b1;
                    if (base0) { b0 = __builtin_nontemporal_load((const f32x4*)(base + off + bj * HALF)); b1 = __builtin_nontemporal_load((const f32x4*)(base + off + bj * HALF + 4)); }
                    else { const hx8 hb = *(const hx8*)(Hb + off + bj * HALF); b0 = (f32x4){(float)hb[0], (float)hb[1], (float)hb[2], (float)hb[3]}; b1 = (f32x4){(float)hb[4], (float)hb[5], (float)hb[6], (float)hb[7]}; }
                    const f32x4 x0 = b0 + acc[ai][bj][m][0], x1 = b1 + acc[ai][bj][m][1];
                    if (out) { __builtin_nontemporal_store(x0, (f32x4*)(out + off + bj * HALF)); __builtin_nontemporal_store(x1, (f32x4*)(out + off + bj * HALF + 4)); }
                    if (Hn) { *(u32x4*)(Hn + off + bj * HALF) = (u32x4){pkh(x0[0], x0[1]), pkh(x0[2], x0[3]), pkh(x1[0], x1[1]), pkh(x1[2], x1[3])};
                        s += ((x0[0] * x0[0] + x0[1] * x0[1]) + (x0[2] * x0[2] + x0[3] * x0[3])) + ((x1[0] * x1[0] + x1[1] * x1[1]) + (x1[2] * x1[2] + x1[3] * x1[3])); } }
                if (Hn) { s += __shfl_xor(s, 16); s += __shfl_xor(s, 32); if (fq == 0) atomicAdd(ssqn + row0 + ai * HALF + m * 16, s); } }
    }
};
template <class Epi, class Sched, bool ALIGN_EPI = false, bool SP2 = false>
__device__ __forceinline__ void gemm_phase(PG8_LAS unsigned char* lds, const Gemm g, const Sched& S, const Epi& E) {
    int tid = threadIdx.x; asm volatile("" : "+v"(tid));
    const int wid = __builtin_amdgcn_readfirstlane(tid >> 6), lane = tid & 63, wr = wid >> 2, wc = wid & 3, fr = lane & 15, fq = lane >> 4;
    const int K = g.K, nt = K / BK;
    unsigned voffA[2], voffB[2];
#pragma unroll
    for (int i = 0; i < 2; ++i) { int R, C; stage_rc(tid * 16 + i * 8192, R, C); const int Rb = Epi::PERM ? ((R & ~31) + perm32(R & 31)) : R;
        voffA[i] = (unsigned)(R * K + C) * 2u; voffB[i] = (unsigned)(Rb * K + C) * 2u; }
    const size_t kstep = (size_t)(BK * 2);
    const size_t hstep = (size_t)HALF * K * 2;
    const size_t tstep = 2 * hstep;
    const unsigned ldsw = (unsigned)wid * 1024u;
    const int aoff = lds_byte(wr * 64 + fr, fq * 8), boff = lds_byte(wc * 32 + fr, fq * 8);
#define PG8_SA(b, h) (((b) * 2 + (h)) * HTB)
#define PG8_SB(b, h) ((4 + (b) * 2 + (h)) * HTB)
#define PG8_STAGE(bufoff, gbase, voff) do { _Pragma("unroll") for (int _i = 0; _i < 2; ++_i) \
        __builtin_amdgcn_global_load_lds((const unsigned*)((const char*)(gbase) + (voff)[_i]), (PG8_LAS unsigned*)(lds + (bufoff) + ldsw + _i * 8192), 16, 0, 0); } while (0)
#define PG8_LDA(dst, b, h) do { _Pragma("unroll") for (int m = 0; m < 4; ++m) _Pragma("unroll") for (int k = 0; k < 2; ++k) dst[m][k] = *(const PG8_LAS bf16x8*)(lds + PG8_SA(b, h) + aoff + m * 2048 + k * 1024); } while (0)
#define PG8_LDB(dst, b, h) do { _Pragma("unroll") for (int n = 0; n < 2; ++n) _Pragma("unroll") for (int k = 0; k < 2; ++k) dst[n][k] = *(const PG8_LAS bf16x8*)(lds + PG8_SB(b, h) + boff + n * 2048 + k * 1024); } while (0)
#define PG8_MMA(ai, bj, At, Bt) do { __builtin_amdgcn_s_setprio(1); _Pragma("unroll") for (int m = 0; m < 4; ++m) _Pragma("unroll") for (int n = 0; n < 2; ++n) _Pragma("unroll") for (int k = 0; k < 2; ++k) \
        acc[ai][bj][m][n] = __builtin_amdgcn_mfma_f32_16x16x32_f16(Bt[n][k], At[m][k], acc[ai][bj][m][n], 0, 0, 0); __builtin_amdgcn_s_setprio(0); } while (0)
#define PG8_WAIT_V(n) asm volatile("s_waitcnt vmcnt(" #n ")" ::: "memory")
#define PG8_WAIT_L(n) asm volatile("s_waitcnt lgkmcnt(" #n ")" ::: "memory")
#define PG8_BAR __builtin_amdgcn_s_barrier()
#define PG8_SCHED __builtin_amdgcn_sched_barrier(0)
    Unit cur, nxt; int ui = 0;
    if (!S.next(0, cur)) return;
    f32x4 acc[2][2][4][2];
#pragma unroll
    for (int a = 0; a < 2; ++a)
#pragma unroll
        for (int b = 0; b < 2; ++b)
#pragma unroll
            for (int m = 0; m < 4; ++m)
#pragma unroll
                for (int n = 0; n < 2; ++n) acc[a][b][m][n] = (f32x4){0.f, 0.f, 0.f, 0.f};
    bf16x8 At[4][2], B0[2][2], B1[2][2];
    const char* cA = (const char*)g.A + (size_t)cur.pm * tstep; const char* cB = (const char*)g.Bt + (size_t)cur.pn * tstep;
    S.a_ready(cur);
    if constexpr (SP2) {
        PG8_STAGE(PG8_SB(0, 0), cB, voffB); PG8_STAGE(PG8_SB(0, 1), cB + hstep, voffB); PG8_STAGE(PG8_SA(0, 0), cA, voffA); PG8_STAGE(PG8_SA(0, 1), cA + hstep, voffA);
        if (wr == 1) PG8_BAR;
        PG8_WAIT_V(2); PG8_BAR;
        PG8_STAGE(PG8_SB(1, 0), cB + kstep, voffB); PG8_STAGE(PG8_SA(1, 0), cA + kstep, voffA); PG8_STAGE(PG8_SB(1, 1), cB + hstep + kstep, voffB);
        PG8_WAIT_V(6); PG8_BAR;
    } else {
        PG8_STAGE(PG8_SB(0, 0), cB, voffB); PG8_STAGE(PG8_SA(0, 0), cA, voffA); PG8_STAGE(PG8_SB(0, 1), cB + hstep, voffB); PG8_STAGE(PG8_SA(0, 1), cA + hstep, voffA);
        if (wr == 1) PG8_BAR;
        PG8_WAIT_V(4); PG8_BAR;
        PG8_STAGE(PG8_SB(1, 0), cB + kstep, voffB); PG8_STAGE(PG8_SA(1, 0), cA + kstep, voffA); PG8_STAGE(PG8_SB(1, 1), cB + hstep + kstep, voffB);
        PG8_WAIT_V(6); PG8_BAR;
    }
    for (;;) {
        const bool has_next = S.next(ui + 1, nxt);
        const char* nA = has_next ? (const char*)g.A + (size_t)nxt.pm * tstep : cA; const char* nB = has_next ? (const char*)g.Bt + (size_t)nxt.pn * tstep : cB;
        for (int t = 0; t < nt; t += 2) {
            const bool last = (t == nt - 2);
            const char* a1 = cA + (size_t)(t + 1) * kstep;
            const char* a2 = last ? nA : cA + (size_t)(t + 2) * kstep; const char* b2 = last ? nB : cB + (size_t)(t + 2) * kstep;
            const char* a3 = a2 + kstep; const char* b3 = b2 + kstep;
            if (last && has_next) S.a_ready(nxt);
            if constexpr (SP2) {
            PG8_LDB(B0, 0, 0); PG8_LDB(B1, 0, 1); PG8_SCHED; PG8_LDA(At, 0, 0); PG8_STAGE(PG8_SA(1, 1), a1 + hstep, voffA);
            PG8_WAIT_V(8); PG8_WAIT_L(0); PG8_BAR; PG8_MMA(0, 0, At, B0); PG8_MMA(0, 1, At, B1); PG8_BAR; PG8_SCHED;
            PG8_LDA(At, 0, 1); PG8_STAGE(PG8_SB(0, 0), b2, voffB); PG8_STAGE(PG8_SB(0, 1), b2 + hstep, voffB); PG8_STAGE(PG8_SA(0, 0), a2, voffA);
            PG8_WAIT_V(8); PG8_WAIT_L(0); PG8_BAR; PG8_MMA(1, 0, At, B0); PG8_MMA(1, 1, At, B1); PG8_BAR; PG8_SCHED;
            PG8_LDB(B0, 1, 0); PG8_LDB(B1, 1, 1); PG8_SCHED; PG8_LDA(At, 1, 0); PG8_STAGE(PG8_SA(0, 1), a2 + hstep, voffA);
            PG8_WAIT_V(8); PG8_WAIT_L(0); PG8_BAR; PG8_MMA(0, 0, At, B0); PG8_MMA(0, 1, At, B1); PG8_BAR; PG8_SCHED;
            PG8_LDA(At, 1, 1); PG8_STAGE(PG8_SB(1, 0), b3, voffB); PG8_STAGE(PG8_SB(1, 1), b3 + hstep, voffB); PG8_STAGE(PG8_SA(1, 0), a3, voffA);
            PG8_WAIT_V(8); PG8_WAIT_L(0); PG8_BAR; PG8_MMA(1, 0, At, B0); PG8_MMA(1, 1, At, B1); PG8_BAR; PG8_SCHED;
            } else {
            PG8_LDB(B0, 0, 0); PG8_SCHED; PG8_LDA(At, 0, 0); PG8_STAGE(PG8_SA(1, 1), a1 + hstep, voffA);
            PG8_WAIT_L(8); PG8_BAR; PG8_WAIT_L(0); PG8_MMA(0, 0, At, B0); PG8_BAR; PG8_SCHED;
            PG8_LDB(B1, 0, 1); PG8_STAGE(PG8_SB(0, 0), b2, voffB);
            PG8_BAR; PG8_WAIT_L(0); PG8_MMA(0, 1, At, B1); PG8_BAR;
            PG8_LDA(At, 0, 1); PG8_STAGE(PG8_SA(0, 0), a2, voffA);
            PG8_BAR; PG8_WAIT_L(0); PG8_MMA(1, 0, At, B0); PG8_BAR; PG8_SCHED;
            PG8_STAGE(PG8_SB(0, 1), b2 + hstep, voffB);
            PG8_WAIT_V(6); PG8_BAR; PG8_MMA(1, 1, At, B1); PG8_BAR;
            PG8_LDB(B0, 1, 0); PG8_SCHED; PG8_LDA(At, 1, 0); PG8_STAGE(PG8_SA(0, 1), a2 + hstep, voffA);
            PG8_WAIT_L(8); PG8_BAR; PG8_WAIT_L(0); PG8_MMA(0, 0, At, B0); PG8_BAR; PG8_SCHED;
            PG8_LDB(B1, 1, 1); PG8_STAGE(PG8_SB(1, 0), b3, voffB);
            PG8_BAR; PG8_WAIT_L(0); PG8_MMA(0, 1, At, B1); PG8_BAR;
            PG8_LDA(At, 1, 1); PG8_STAGE(PG8_SA(1, 0), a3, voffA);
            PG8_BAR; PG8_WAIT_L(0); PG8_MMA(1, 0, At, B0); PG8_BAR; PG8_SCHED;
            PG8_STAGE(PG8_SB(1, 1), b3 + hstep, voffB);
            PG8_WAIT_V(6); PG8_BAR; PG8_MMA(1, 1, At, B1); PG8_BAR;
            }
        }
        if constexpr (ALIGN_EPI) { if (wr == 0) PG8_BAR; }
        if constexpr (!Epi::AFTER_DRAIN) { E(acc, cur, wr, wc, fr, fq); S.done(cur); }
        if (!has_next) break;
#pragma unroll
        for (int a = 0; a < 2; ++a)
#pragma unroll
            for (int b = 0; b < 2; ++b)
#pragma unroll
                for (int m = 0; m < 4; ++m)
#pragma unroll
                    for (int n = 0; n < 2; ++n) acc[a][b][m][n] = (f32x4){0.f, 0.f, 0.f, 0.f};
        cur = nxt; cA = nA; cB = nB; ++ui;
        if constexpr (ALIGN_EPI) { if (wr == 1) PG8_BAR; }
    }
    PG8_WAIT_V(0);
    if constexpr (!ALIGN_EPI) { if (wr == 0) PG8_BAR; }
    PG8_BAR;
    if constexpr (Epi::AFTER_DRAIN) { E.fused(acc, cur, wr, wc, fr, fq, lds, wid, lane); S.done(cur); }
#undef PG8_SA
#undef PG8_SB
#undef PG8_STAGE
#undef PG8_LDA
#undef PG8_LDB
#undef PG8_MMA
#undef PG8_WAIT_V
#undef PG8_WAIT_L
#undef PG8_BAR
#undef PG8_SCHED
}
}
namespace att {
constexpr int D = 128, NW = 8, QBLK = 32, KVBLK = 64;
constexpr float SCALE = 0.088388347648318440f;
constexpr float THR = 8.f;
constexpr int SHM_V = KVBLK * D * 2, SHM_K = KVBLK * D * 2, SHM_ATTN = 2 * SHM_V + 2 * SHM_K + NW * 64 * 4;
#define KSWZ(row, colB) ((row) * 256 + ((colB) ^ (((row) & 7) << 4)))
#define SBAR() __builtin_amdgcn_sched_barrier(0)
__device__ __forceinline__ int crow(int r, int hi) { return (r & 3) + 8 * (r >> 2) + 4 * hi; }

__device__ __forceinline__ void partialSM(f32x16& p0, f32x16& p1, float& m_reg, float& mn, float& alpha) {
  constexpr float C = SCALE * 1.4426950408889634f;
  float pmax = p0[0];
#pragma unroll
  for (int r = 1; r < 16; ++r) pmax = fmaxf(pmax, p0[r]);
#pragma unroll
  for (int r = 0; r < 16; ++r) pmax = fmaxf(pmax, p1[r]);
  { auto rr = __builtin_amdgcn_permlane32_swap(__float_as_uint(pmax), __float_as_uint(pmax), false, false);
    pmax = fmaxf(__uint_as_float(rr[0]), __uint_as_float(rr[1])); }
  if (__builtin_expect(__all(pmax - m_reg <= THR / SCALE), 1)) { mn = m_reg; alpha = 1.f; }
  else { mn = fmaxf(m_reg, pmax); alpha = __builtin_amdgcn_exp2f((m_reg - mn) * C); m_reg = mn; }
  float mnC = -mn * C;
#pragma unroll
  for (int r = 0; r < 16; ++r) p0[r] = fmaf(p0[r], C, mnC);
#pragma unroll
  for (int r = 0; r < 16; ++r) p1[r] = fmaf(p1[r], C, mnC);
#pragma unroll
  for (int r = 0; r < 16; ++r) p0[r] = __builtin_amdgcn_exp2f(p0[r]);
}
__device__ __forceinline__ void finishSM(f32x16& p0, f32x16& p1, float alpha, float& l_reg, hx8& pa0, hx8& pa1, hx8& pa2, hx8& pa3) {
#pragma unroll
  for (int r = 0; r < 16; ++r) p1[r] = __builtin_amdgcn_exp2f(p1[r]);
  float ps = 0;
#pragma unroll
  for (int r = 0; r < 16; ++r) ps += p0[r];
#pragma unroll
  for (int r = 0; r < 16; ++r) ps += p1[r];
  { auto rr = __builtin_amdgcn_permlane32_swap(__float_as_uint(ps), __float_as_uint(ps), false, false);
    ps = __uint_as_float(rr[0]) + __uint_as_float(rr[1]); }
  l_reg = l_reg * alpha + ps;
#define PK4(P, BASE, OUT) do { unsigned a0 = pkh(P[BASE + 0], P[BASE + 1]), a1 = pkh(P[BASE + 2], P[BASE + 3]);   \
    unsigned b0 = pkh(P[BASE + 4], P[BASE + 5]), b1 = pkh(P[BASE + 6], P[BASE + 7]);                              \
    auto r0 = __builtin_amdgcn_permlane32_swap(a0, b0, false, false); auto r1 = __builtin_amdgcn_permlane32_swap(a1, b1, false, false); \
    u32x4 w = {r0[0], r1[0], r0[1], r1[1]}; OUT = __builtin_bit_cast(hx8, w); } while (0)
  PK4(p0, 0, pa0); PK4(p0, 8, pa1); PK4(p1, 0, pa2); PK4(p1, 8, pa3);
#undef PK4
}
template <bool QLDS>
__device__ __forceinline__ void qkt(f32x16& p0, f32x16& p1, const LAS char* Ks, const hx8* qr, const LAS char* qlds, int r32, int hi) {
  p0 = f32x16{}; p1 = f32x16{};
  const int B = (r32 * 256 + ((hi * 16) ^ ((r32 & 1) << 4))) | (((r32 >> 1) & 3) << 5);
#pragma unroll
  for (int d0 = 0; d0 < 8; ++d0) { const LAS char* kp = Ks + (B ^ ((d0 & 3) << 5)) + (d0 >> 2) * 128;
    hx8 b0 = *(const LAS hx8*)kp;
    hx8 b1 = *(const LAS hx8*)(kp + 8192);
    const hx8 q = QLDS ? *(const LAS hx8*)(qlds + d0 * 1024) : qr[d0];
    p0 = __builtin_amdgcn_mfma_f32_32x32x16_f16(b0, q, p0, 0, 0, 0);
    p1 = __builtin_amdgcn_mfma_f32_32x32x16_f16(b1, q, p1, 0, 0, 0); }
}
__device__ __forceinline__ void wmask(f32x16& p0, f32x16& p1, int dq, int hi) {
#pragma unroll
  for (int r = 0; r < 16; ++r) { const int d0 = dq - crow(r, hi), d1 = d0 - 32;
    if (d0 > 128 || d0 < -128) p0[r] = -1e30f;
    if (d1 > 128 || d1 < -128) p1[r] = -1e30f; }
}
__device__ __forceinline__ int v_st(int k, int c) { const int kk = (k & ~0xC) | ((k & 4) << 1) | ((k & 8) >> 1); return ((kk >> 3) * 4 + (c >> 5)) * 512 + ((kk & 7) * 32 + (c & 31)) * 2; }
__device__ __forceinline__ int v_rd_base(int lane) { return ((lane & 3) << 3) | (((lane >> 2) & 3) << 6) | (((lane >> 4) & 1) << 5) | (((lane >> 5) & 1) << 8); }
constexpr int v_rd_off(int d0, int ks, int half) { return d0 * 512 + ks * 4096 + half * 2048; }
template <int OFF> __device__ __forceinline__ s16x4 tr_read(int vb) {
  s16x4 r; asm volatile("ds_read_b64_tr_b16 %0, %1 offset:%2" : "=&v"(r) : "v"(vb), "i"(OFF) : "memory"); return r;
}
template <int D0> __device__ __forceinline__ void pv_one(f32x16& od, int vb, hx8 pa0, hx8 pa1, hx8 pa2, hx8 pa3) {
  const s16x4 l0 = tr_read<v_rd_off(D0, 0, 0)>(vb), h0 = tr_read<v_rd_off(D0, 0, 1)>(vb), l1 = tr_read<v_rd_off(D0, 1, 0)>(vb), h1 = tr_read<v_rd_off(D0, 1, 1)>(vb);
  const s16x4 l2 = tr_read<v_rd_off(D0, 2, 0)>(vb), h2 = tr_read<v_rd_off(D0, 2, 1)>(vb), l3 = tr_read<v_rd_off(D0, 3, 0)>(vb), h3 = tr_read<v_rd_off(D0, 3, 1)>(vb);
  asm volatile("s_waitcnt lgkmcnt(0)" ::: "memory"); SBAR();
#define PK(L, H) __builtin_bit_cast(hx8, (s16x8){L[0], L[1], L[2], L[3], H[0], H[1], H[2], H[3]})
  od = __builtin_amdgcn_mfma_f32_32x32x16_f16(pa0, PK(l0, h0), od, 0, 0, 0);
  od = __builtin_amdgcn_mfma_f32_32x32x16_f16(pa1, PK(l1, h1), od, 0, 0, 0);
  od = __builtin_amdgcn_mfma_f32_32x32x16_f16(pa2, PK(l2, h2), od, 0, 0, 0);
  od = __builtin_amdgcn_mfma_f32_32x32x16_f16(pa3, PK(l3, h3), od, 0, 0, 0);
#undef PK
}
__device__ __forceinline__ void pv_d0(f32x16* o, int vb, hx8 pa0, hx8 pa1, hx8 pa2, hx8 pa3) {
  pv_one<0>(o[0], vb, pa0, pa1, pa2, pa3); pv_one<1>(o[1], vb, pa0, pa1, pa2, pa3); pv_one<2>(o[2], vb, pa0, pa1, pa2, pa3); pv_one<3>(o[3], vb, pa0, pa1, pa2, pa3);
}

template <bool WIN, int LD, int SD>
__device__ __forceinline__ void attn_unit(const u16* __restrict__ Qb, const u16* __restrict__ Kh, const u16* __restrict__ Vh, const u16* __restrict__ Gb,
                                          u16* __restrict__ Yb, int NT, const float* __restrict__ sinkp, int dq0, LAS char* lds,
                                          const float* __restrict__ qn, const f32x2* __restrict__ tabA, const f32x2* __restrict__ tabB_, int t0) {
  constexpr int LDK = 128;
  int tid = threadIdx.x; asm volatile("" : "+v"(tid));
  const int wid = tid >> 6, lane = tid & 63, r32 = lane & 31, hi = lane >> 5;
  LAS char* V_lds = lds; LAS char* K_lds = lds + 2 * SHM_V;
  LAS float* ws = (LAS float*)(lds + 2 * SHM_V + 2 * SHM_K) + wid * 64; LAS float* li_l = ws; LAS float* al_l = ws + 32;
  const int wrow = WIN ? (wid & 3) * QBLK : wid * QBLK, hcol = WIN ? (wid >> 2) * 128 : 0;
  LAS char* qlds = lds + SHM_ATTN + wid * 8192 + lane * 16;
  float m_reg = WIN ? sinkp[wid >> 2] * (1.0f / SCALE) : -1e30f, l_reg = WIN ? 1.0f : 0.f; f32x16 o[4] = {}; hx8 qr[8];
  const u16* Qw = Qb + hcol + (long)(wrow + r32) * LD + hi * 8;
  const int sr = tid >> 4, sc = (tid & 15) * 8, vst0 = v_st(sr, sc), ksw0 = KSWZ(sr, sc * 2);
  const int vb0 = (int)(uintptr_t)V_lds + v_rd_base(lane);
  const int dqw = dq0 + wrow + r32;
  struct { hx8 vs0, vs1, ks0, ks1; } sr_[SD];
#define SLOAD(i, k0) do { sr_[i].vs0 = *(const hx8*)(&Vh[(long)((k0) + sr) * LDK + sc]); sr_[i].vs1 = *(const hx8*)(&Vh[(long)((k0) + 32 + sr) * LDK + sc]); \
    sr_[i].ks0 = *(const hx8*)(&Kh[(long)((k0) + sr) * LDK + sc]); sr_[i].ks1 = *(const hx8*)(&Kh[(long)((k0) + 32 + sr) * LDK + sc]); } while (0)
#define SWRITE(b, i) do { *(LAS hx8*)(V_lds + (b) * SHM_V + vst0) = sr_[i].vs0;          \
    *(LAS hx8*)(V_lds + (b) * SHM_V + vst0 + 8192) = sr_[i].vs1;                          \
    *(LAS hx8*)(K_lds + (b) * SHM_K + ksw0) = sr_[i].ks0;                                \
    *(LAS hx8*)(K_lds + (b) * SHM_K + ksw0 + 8192) = sr_[i].ks1; } while (0)
#define SWAIT() do { if (SD == 2) asm volatile("s_waitcnt vmcnt(4)" ::: "memory"); else asm volatile("s_waitcnt vmcnt(0)" ::: "memory"); } while (0)
#define RESC(a) do { if (__any((a) < 1.f)) { if (hi == 0) al_l[r32] = (a); asm volatile("s_waitcnt lgkmcnt(0)" ::: "memory"); \
    _Pragma("unroll") for (int d = 0; d < 4; ++d) _Pragma("unroll") for (int r = 0; r < 16; ++r) o[d][r] *= al_l[crow(r, hi)]; } } while (0)
  constexpr int SE = 0, SO = SD - 1;
  SLOAD(SE, 0);
  {
    float y[8][8]; float ss = 0.f;
#pragma unroll
    for (int d0 = 0; d0 < 8; ++d0) { const hx8 v = *(const hx8*)(Qw + d0 * 16);
#pragma unroll
      for (int j = 0; j < 8; ++j) { y[d0][j] = (float)v[j]; ss += y[d0][j] * y[d0][j]; } }
    { auto rr = __builtin_amdgcn_permlane32_swap(__float_as_uint(ss), __float_as_uint(ss), false, false); ss = __uint_as_float(rr[0]) + __uint_as_float(rr[1]); }
    const float rstd = 1.0f / sqrtf(ss * (1.f / 128.f) + 1e-6f);
#pragma unroll
    for (int d0 = 0; d0 < 8; ++d0) { const f32x4 g0 = *(const f32x4*)(qn + d0 * 16 + hi * 8), g1 = *(const f32x4*)(qn + d0 * 16 + hi * 8 + 4);
#pragma unroll
      for (int j = 0; j < 4; ++j) { y[d0][j] *= rstd * g0[j]; y[d0][4 + j] *= rstd * g1[j]; } }
    const int t = t0 + wrow + r32;
    if (WIN) {
      const f32x4* tp = (const f32x4*)(tabA + t * 16 + hi * 8);
#pragma unroll
      for (int j2 = 0; j2 < 4; ++j2) { const f32x4 cs = tp[j2];
        { const float x1 = y[0][2 * j2], x2 = y[1][2 * j2]; y[0][2 * j2] = x1 * cs.x - x2 * cs.y; y[1][2 * j2] = x2 * cs.x + x1 * cs.y; }
        { const float x1 = y[0][2 * j2 + 1], x2 = y[1][2 * j2 + 1]; y[0][2 * j2 + 1] = x1 * cs.z - x2 * cs.w; y[1][2 * j2 + 1] = x2 * cs.z + x1 * cs.w; } }
    } else {
#pragma unroll
      for (int hf = 0; hf < 2; ++hf)
#pragma unroll
        for (int dd = 0; dd < 2; ++dd) { const int da = hf * 4 + dd, db = da + 2;
          const f32x4* tp = (const f32x4*)((hf == 0 ? tabA + (t >> 6) * 32 : tabB_ + (t & 63) * 32) + dd * 16 + hi * 8);
#pragma unroll
          for (int j2 = 0; j2 < 4; ++j2) { const f32x4 cs = tp[j2];
            { const float x1 = y[da][2 * j2], x2 = y[db][2 * j2]; y[da][2 * j2] = x1 * cs.x - x2 * cs.y; y[db][2 * j2] = x2 * cs.x + x1 * cs.y; }
            { const float x1 = y[da][2 * j2 + 1], x2 = y[db][2 * j2 + 1]; y[da][2 * j2 + 1] = x1 * cs.z - x2 * cs.w; y[db][2 * j2 + 1] = x2 * cs.z + x1 * cs.w; } } }
    }
#pragma unroll
    for (int d0 = 0; d0 < 8; ++d0) { u32x4 w = {pkh(y[d0][0], y[d0][1]), pkh(y[d0][2], y[d0][3]), pkh(y[d0][4], y[d0][5]), pkh(y[d0][6], y[d0][7])}; qr[d0] = __builtin_bit_cast(hx8, w);
      if (WIN) *(LAS hx8*)(qlds + d0 * 1024) = qr[d0]; }
  }
  f32x16 pA0, pA1, pB0, pB1; float mnA, mnB, alA, alB; hx8 pa0, pa1, pa2, pa3;
  asm volatile("s_waitcnt vmcnt(0)" ::: "memory"); SWRITE(0, SE); __syncthreads();
  qkt<WIN>(pA0, pA1, K_lds, qr, qlds, r32, hi); if (WIN) wmask(pA0, pA1, dqw, hi); partialSM(pA0, pA1, m_reg, mnA, alA);
  SLOAD(SO, KVBLK); if (SD == 2) { if (2 < NT) SLOAD(SE, 2 * KVBLK); }
  SWAIT(); SWRITE(1, SO); __syncthreads();
  for (int j = 1; j + 1 < NT; j += 2) {
    SBAR(); qkt<WIN>(pB0, pB1, K_lds + SHM_K, qr, qlds, r32, hi); if (WIN) wmask(pB0, pB1, dqw - j * KVBLK, hi);
    finishSM(pA0, pA1, alA, l_reg, pa0, pa1, pa2, pa3); SBAR();
    SLOAD(SO, (j + SD) * KVBLK); SBAR();
    pv_d0(o, vb0, pa0, pa1, pa2, pa3); partialSM(pB0, pB1, m_reg, mnB, alB);
    __syncthreads(); SWAIT(); SWRITE(0, SE);
    RESC(alB); __syncthreads();
    SBAR(); qkt<WIN>(pA0, pA1, K_lds, qr, qlds, r32, hi); if (WIN) wmask(pA0, pA1, dqw - (j + 1) * KVBLK, hi);
    finishSM(pB0, pB1, alB, l_reg, pa0, pa1, pa2, pa3); SBAR();
    if (SD == 1 || j + 3 < NT) SLOAD(SE, (j + 1 + SD) * KVBLK); SBAR();
    pv_d0(o, vb0 + SHM_V, pa0, pa1, pa2, pa3); partialSM(pA0, pA1, m_reg, mnA, alA);
    __syncthreads(); SWAIT(); SWRITE(1, SO);
    RESC(alA); __syncthreads();
  }
  const u16* Gw = Gb + hcol + (long)wrow * LD; const int erow = lane >> 4, ech = (lane & 15) * 8;
  hx8 gpre[8];
#pragma unroll
  for (int it = 0; it < 8; ++it) gpre[it] = *(const hx8*)(Gw + (long)(it * 4 + erow) * LD + ech);
  SBAR(); qkt<WIN>(pB0, pB1, K_lds + SHM_K, qr, qlds, r32, hi); if (WIN) wmask(pB0, pB1, dqw - (NT - 1) * KVBLK, hi);
  finishSM(pA0, pA1, alA, l_reg, pa0, pa1, pa2, pa3); SBAR();
  pv_d0(o, vb0, pa0, pa1, pa2, pa3); partialSM(pB0, pB1, m_reg, mnB, alB);
  __syncthreads(); RESC(alB);
  finishSM(pB0, pB1, alB, l_reg, pa0, pa1, pa2, pa3); SBAR();
  pv_d0(o, vb0 + SHM_V, pa0, pa1, pa2, pa3);
  if (hi == 0) li_l[r32] = l_reg; asm volatile("s_waitcnt lgkmcnt(0)" ::: "memory");
  float rli[16];
#pragma unroll
  for (int r = 0; r < 16; ++r) rli[r] = __builtin_amdgcn_rcpf(li_l[crow(r, hi)]);
  LAS u16* img = (LAS u16*)(lds + SHM_ATTN + wid * 8192);
#pragma unroll
  for (int r = 0; r < 16; ++r) { const int orow = crow(r, hi);
#pragma unroll
    for (int d0 = 0; d0 < 4; ++d0) img[orow * 128 + d0 * 32 + r32] = f2h(o[d0][r] * rli[r]); }
  u16* Yw = Yb + hcol + (long)wrow * DM;
#pragma unroll
  for (int it = 0; it < 8; ++it) { const int row = it * 4 + erow;
    const hx8 ov = *(const LAS hx8*)(img + row * 128 + ech), gv = gpre[it];
    u32x4 w = {pkh((float)ov[0] * (float)gv[0], (float)ov[1] * (float)gv[1]), pkh((float)ov[2] * (float)gv[2], (float)ov[3] * (float)gv[3]),
               pkh((float)ov[4] * (float)gv[4], (float)ov[5] * (float)gv[5]), pkh((float)ov[6] * (float)gv[6], (float)ov[7] * (float)gv[7])};
    *(u32x4*)(Yw + (long)row * DM + ech) = w; }
#undef SLOAD
#undef SWRITE
#undef SWAIT
#undef RESC
}
}

constexpr size_t MiB = 1u << 20;
constexpr size_t WS_WIN_AB = 0, WS_WOUT_AB = 44 * MiB, WS_WIN_C = 60 * MiB, WS_WOUT_C = 100 * MiB, WS_TAB = 116 * MiB;
constexpr size_t WS_BAR = WS_TAB + 1 * MiB + 64 * 1024, BAR_BYTES = 16384;
constexpr size_t WS_SSQ = WS_TAB + 1 * MiB + 256 * 1024;
constexpr size_t WS_TABB = WS_TAB, WS_TABR = WS_TAB + 1 * MiB, WS_TABC = WS_TABR + 32768;
constexpr size_t WS_H = 118 * MiB, WS_Y = 278 * MiB, WS_Z = 438 * MiB, WS_KV = 878 * MiB, WS_END = 962 * MiB;
static_assert((size_t)2 * AB_IN * DM * 2 <= 44 * MiB && (size_t)2 * C_IN * DM * 2 <= 40 * MiB && (size_t)MTOK * DM * 2 <= 160 * MiB && (size_t)MTOK * AB_IN * 2 <= 440 * MiB, "ws map");
constexpr int LDS_BYTES = 151552;
constexpr int NPHASE = 17;

struct Args { const float* in[16]; float* out; unsigned char* ws; int ph_lo, ph_hi; };

__device__ __forceinline__ void p0_transpose_item(const float* W, const float* gain, int K, int N, u16* WT, LAS float* scr, int item, int lane) {
    const int nblk = N / 32, kb = item / nblk, nb = item % nblk, k0 = 64 * kb, n0 = 32 * nb;
    float wv[32];
#pragma unroll
    for (int i = 0; i < 32; ++i) { const int kk = 2 * i + (lane >> 5); wv[i] = __builtin_nontemporal_load(W + (size_t)(k0 + kk) * N + n0 + (lane & 31)); }
    const float g0 = gain ? gain[k0 + lane] : 1.0f;
#pragma unroll
    for (int i = 0; i < 32; ++i) { const int kk = 2 * i + (lane >> 5); scr[kk * 33 + (lane & 31)] = wv[i] * __shfl(g0, kk); }
    asm volatile("s_waitcnt lgkmcnt(0)" ::: "memory");
    const int c = lane & 7;
#pragma unroll
    for (int j = 0; j < 4; ++j) { const int n = (lane >> 3) + 8 * j; const LAS float* s = scr + (8 * c) * 33 + n;
        u32x4 o; o.x = pkh(s[0 * 33], s[1 * 33]); o.y = pkh(s[2 * 33], s[3 * 33]); o.z = pkh(s[4 * 33], s[5 * 33]); o.w = pkh(s[6 * 33], s[7 * 33]);
        *(u32x4*)(WT + (size_t)(n0 + n) * K + k0 + 8 * c) = o; }
    asm volatile("s_waitcnt lgkmcnt(0)" ::: "memory");
}
__device__ __forceinline__ void sincos_d(double a, float& s, float& c) {
    double rev = a * 0.15915494309189533577; rev -= __builtin_rint(rev); const double r = rev * 6.283185307179586476925, r2 = r * r;
    double ss = 1.0, cc = 1.0;
#pragma unroll
    for (int k = 12; k >= 1; --k) { ss = 1.0 - ss * r2 / (double)((2 * k) * (2 * k + 1)); cc = 1.0 - cc * r2 / (double)((2 * k - 1) * (2 * k)); }
    s = (float)(ss * r); c = (float)cc;
}
__device__ __forceinline__ void rope_tables(unsigned char* ws, int gtid, int gthreads) {
    const double bB = __builtin_sqrt(__builtin_sqrt(__builtin_sqrt(__builtin_sqrt(1.0 / 500000.0))));
    const double bC = __builtin_sqrt(__builtin_sqrt(__builtin_sqrt(__builtin_sqrt(__builtin_sqrt(1.0 / 10000.0)))));
    f32x2* tB = (f32x2*)(ws + WS_TABB); f32x2* tR = (f32x2*)(ws + WS_TABR); f32x2* tC = (f32x2*)(ws + WS_TABC);
    for (int e = gtid; e < 8192 * 16 + 128 * 32 + 64 * 32; e += gthreads) {
        int pos, i; double base; f32x2* dst;
        if (e < 8192 * 16) { pos = e >> 4; i = e & 15; base = bB; dst = tB + e; }
        else if (e < 8192 * 16 + 128 * 32) { const int f = e - 8192 * 16; pos = f >> 5; i = f & 31; base = bC; dst = tR + f; }
        else { const int f = e - 8192 * 16 - 128 * 32; pos = f >> 5; i = f & 31; base = bC; dst = tC + f; }
        double inv = 1.0; for (int k = 0; k < i; ++k) inv *= base;
        const float invf = (float)inv; const float ang = (float)pos * invf;
        float s, c; sincos_d((double)ang, s, c); *dst = (f32x2){c, s};
    }
}
__device__ __forceinline__ void cvt_phase(const float* x0, const float* x1, u16* H, float* ssq, int gw, int ngw, int lane) {
    for (int m = gw; m < MTOK; m += ngw) {
        const f32x4* xr = (const f32x4*)((m < NTOK_P ? x0 : x1) + (size_t)m * DM) + lane;
        f32x4 v[8]; float s = 0.f;
#pragma unroll
        for (int j = 0; j < 8; ++j) { v[j] = xr[64 * j]; s += (v[j].x * v[j].x + v[j].y * v[j].y) + (v[j].z * v[j].z + v[j].w * v[j].w); }
        s = wave_sum(s); if (lane == 0) ssq[m] = s;
        u32x2* o8 = (u32x2*)(H + (size_t)m * DM) + lane;
#pragma unroll
        for (int j = 0; j < 8; ++j) o8[64 * j] = (u32x2){pkh(v[j].x, v[j].y), pkh(v[j].z, v[j].w)};
    }
}
template <bool ODD>
__device__ __forceinline__ void prep_phase(u16* KV, const float* kn, const unsigned char* ws, int gw, int ngw, int lane) {
    constexpr int NKH = ODD ? 4 : 2;
    const f32x2* tB = (const f32x2*)(ws + WS_TABB); const f32x2* tR = (const f32x2*)(ws + WS_TABR); const f32x2* tC = (const f32x2*)(ws + WS_TABC);
    const int sub = lane >> 4, ls = lane & 15;
    const f32x4 g0 = *(const f32x4*)(kn + ls * 8), g1 = *(const f32x4*)(kn + ls * 8 + 4);
    constexpr int NB = 5;
    for (int it0 = gw; it0 < MTOK * NKH / 4; it0 += NB * ngw) {
        hx8 vv[NB];
#pragma unroll
        for (int b = 0; b < NB; ++b) { const int it = it0 + b * ngw; if (it < MTOK * NKH / 4) vv[b] = *(const hx8*)(KV + (size_t)(it * 4 + sub) * 128 + ls * 8); }
#pragma unroll
        for (int b = 0; b < NB; ++b) { const int it = it0 + b * ngw; if (it >= MTOK * NKH / 4) break;
        const int R = it * 4 + sub, kh = R / MTOK, row = R - kh * MTOK;
        const int t = row < NTOK_P ? (row & (SEQ_P - 1)) : ((row - NTOK_P) & (SEQ_S - 1));
        u16* p = KV + (size_t)R * 128 + ls * 8;
        const hx8 v = vv[b]; float y[8]; float ss = 0.f;
#pragma unroll
        for (int j = 0; j < 8; ++j) { y[j] = (float)v[j]; ss += y[j] * y[j]; }
        ss += __shfl_xor(ss, 1); ss += __shfl_xor(ss, 2); ss += __shfl_xor(ss, 4); ss += __shfl_xor(ss, 8);
        const float rstd = 1.0f / sqrtf(ss * (1.f / 128.f) + EPS);
#pragma unroll
        for (int j = 0; j < 4; ++j) { y[j] *= rstd * g0[j]; y[4 + j] *= rstd * g1[j]; }
        if (ODD) {
            const f32x4* tp = (const f32x4*)((ls < 8 ? tR + (t >> 6) * 32 : tC + (t & 63) * 32) + (ls & 3) * 8);
            const bool second = (ls & 4) != 0;
#pragma unroll
            for (int j2 = 0; j2 < 4; ++j2) { const f32x4 cs = tp[j2];
                const float pa = __shfl_xor(y[2 * j2], 4), pb = __shfl_xor(y[2 * j2 + 1], 4);
                y[2 * j2] = y[2 * j2] * cs.x + (second ? pa : -pa) * cs.y; y[2 * j2 + 1] = y[2 * j2 + 1] * cs.z + (second ? pb : -pb) * cs.w; }
        } else {
            const f32x4* tp = (const f32x4*)(tB + t * 16 + (ls & 1) * 8);
            const bool second = (ls & 2) != 0;
#pragma unroll
            for (int j2 = 0; j2 < 4; ++j2) { const f32x4 cs = tp[j2];
                const float pa = __shfl_xor(y[2 * j2], 2), pb = __shfl_xor(y[2 * j2 + 1], 2);
                const float ya = y[2 * j2] * cs.x + (second ? pa : -pa) * cs.y, yb = y[2 * j2 + 1] * cs.z + (second ? pb : -pb) * cs.w;
                if (ls < 4) { y[2 * j2] = ya; y[2 * j2 + 1] = yb; } }
        }
        *(u32x4*)p = (u32x4){pkh(y[0], y[1]), pkh(y[2], y[3]), pkh(y[4], y[5]), pkh(y[6], y[7])};
        }
    }
}
__device__ __forceinline__ void mixer_a_phase(const u16* Z, u16* Y, const float* vnorm, const float* wsp, const float* bsp, int c, int G, LAS char* lds) {
    constexpr int PIT = 136, MP = 132, NU = (MTOK / 128) * 8;
    int tid = threadIdx.x; asm volatile("" : "+v"(tid));
    const int wid = tid >> 6, lane = tid & 63, r32 = lane & 31, hi = lane >> 5;
    LAS u16* vnT = (LAS u16*)lds; LAS float* mx = (LAS float*)(lds + 36864);
    const int q = tid >> 2, part = tid & 3, pb = wid & 3, dh = wid >> 2;
    hx8 nv[4], nu[4], ng[4];
#define MA_LOAD(unit) do { const u16* src_ = Z + (size_t)(((unit) >> 3) * 128 + q) * AB_IN + ((unit) & 7) * 128 + part * 32; \
    _Pragma("unroll") for (int j = 0; j < 4; ++j) { nv[j] = *(const hx8*)(src_ + 1024 + 8 * j); nu[j] = *(const hx8*)(src_ + 8 * j); ng[j] = *(const hx8*)(src_ + 2048 + 8 * j); } } while (0)
    int gcur = -1; hx8 af[8]; float bsv[16]; float gnv[32];
    if (c < NU) MA_LOAD(c);
    for (int ua = c; ua < NU; ua += G) {
        const int chunk = ua >> 3, g = ua & 7;
        hx8 v[4], u[4], gt[4];
#pragma unroll
        for (int j = 0; j < 4; ++j) { v[j] = nv[j]; u[j] = nu[j]; gt[j] = ng[j]; }
        if (g != gcur) {
            const float* wrow = wsp + (size_t)g * 128 * 128 + (size_t)(pb * 32 + r32) * 128 + hi * 8;
#pragma unroll
            for (int ks = 0; ks < 8; ++ks) { const f32x4 a0 = *(const f32x4*)(wrow + ks * 16), a1 = *(const f32x4*)(wrow + ks * 16 + 4);
                af[ks] = (hx8){(_Float16)a0.x, (_Float16)a0.y, (_Float16)a0.z, (_Float16)a0.w, (_Float16)a1.x, (_Float16)a1.y, (_Float16)a1.z, (_Float16)a1.w}; }
#pragma unroll
            for (int r = 0; r < 16; ++r) bsv[r] = bsp[g * 128 + pb * 32 + att::crow(r, hi)];
#pragma unroll
            for (int j = 0; j < 8; ++j) { const f32x4 t4 = *(const f32x4*)(vnorm + g * 128 + part * 32 + 4 * j); gnv[4 * j] = t4.x; gnv[4 * j + 1] = t4.y; gnv[4 * j + 2] = t4.z; gnv[4 * j + 3] = t4.w; }
            gcur = g;
        }
        { float ss = 0.f;
#pragma unroll
          for (int j = 0; j < 4; ++j)
#pragma unroll
              for (int e = 0; e < 8; ++e) { const float f = (float)v[j][e]; ss += f * f; }
          ss += __shfl_xor(ss, 1); ss += __shfl_xor(ss, 2);
          const float rstd = 1.0f / sqrtf(ss * (1.f / 128.f) + EPS);
#pragma unroll
          for (int j = 0; j < 4; ++j)
#pragma unroll
              for (int e = 0; e < 8; ++e) vnT[(part * 32 + j * 8 + e) * PIT + q] = f2h((float)v[j][e] * rstd * gnv[j * 8 + e]); }
        __syncthreads();
        if (ua + G < NU) MA_LOAD(ua + G);
        f32x16 acc0 = {}, acc1 = {};
#pragma unroll
        for (int ks = 0; ks < 8; ++ks) {
            const hx8 b0 = *(const LAS hx8*)(vnT + (dh * 64 + r32) * PIT + ks * 16 + hi * 8);
            const hx8 b1 = *(const LAS hx8*)(vnT + (dh * 64 + 32 + r32) * PIT + ks * 16 + hi * 8);
            acc0 = __builtin_amdgcn_mfma_f32_32x32x16_f16(af[ks], b0, acc0, 0, 0, 0);
            acc1 = __builtin_amdgcn_mfma_f32_32x32x16_f16(af[ks], b1, acc1, 0, 0, 0);
        }
#pragma unroll
        for (int r = 0; r < 16; ++r) { LAS float* mp = mx + (pb * 32 + att::crow(r, hi)) * MP + dh * 64 + r32; mp[0] = acc0[r] + bsv[r]; mp[32] = acc1[r] + bsv[r]; }
        __syncthreads();
        { u16* yr = Y + (size_t)(chunk * 128 + q) * DM + g * 128 + part * 32; const LAS float* mr = mx + q * MP + part * 32;
#pragma unroll
          for (int j = 0; j < 4; ++j) { const f32x4 m0 = *(const LAS f32x4*)(mr + 8 * j), m1 = *(const LAS f32x4*)(mr + 8 * j + 4);
              float o[8];
#pragma unroll
              for (int e = 0; e < 4; ++e) { o[e] = (float)u[j][e] * m0[e] * (float)gt[j][e]; o[4 + e] = (float)u[j][4 + e] * m1[e] * (float)gt[j][4 + e]; }
              *(u32x4*)(yr + 8 * j) = (u32x4){pkh(o[0], o[1]), pkh(o[2], o[3]), pkh(o[4], o[5]), pkh(o[6], o[7])}; } }
    }
    __syncthreads();
#undef MA_LOAD
}

#define XB_TMO      128
#define XB_XCNT(j)  (256  + 64 * (j))
#define XB_XSUB(j)  (1280 + 64 * (j))
#define XB_XGEN(j)  (2304 + 64 * (j))
#define XB_TOP      3328
#define XB_TOPGEN   3392
#define XCD_BAR_WORDS 3456
#define XB_SPIN_CAP (1u << 18)

__device__ __forceinline__ unsigned xb_ld(unsigned* p)              { return __hip_atomic_load(p, __ATOMIC_RELAXED, __HIP_MEMORY_SCOPE_AGENT); }
__device__ __forceinline__ unsigned xb_add(unsigned* p, unsigned v) { return __hip_atomic_fetch_add(p, v, __ATOMIC_RELAXED, __HIP_MEMORY_SCOPE_AGENT); }
__device__ __forceinline__ unsigned xb_xcc_id() { return (unsigned)__builtin_amdgcn_s_getreg((3 << 11) | 20) & 0xFu; }
#define XB_SPIN(cond, bar) do { unsigned _sp = 0; while (cond) { __builtin_amdgcn_s_sleep(1); \
    if ((++_sp & 255u) == 0u) { if (xb_ld(&(bar)[XB_TMO])) break; if (_sp > XB_SPIN_CAP) { atomicAdd(&(bar)[XB_TMO], 1u); break; } } } } while (0)

struct XcdBarrier {
    unsigned* bar; unsigned x;
    volatile LAS unsigned* st;
};

__device__ __forceinline__ XcdBarrier xcd_barrier_post(unsigned* bar, volatile LAS unsigned* st) {
    XcdBarrier b; b.bar = bar; b.x = xb_xcc_id(); b.st = st;
    if (threadIdx.x == 0) (void)xb_add(&bar[XB_XCNT(b.x)], 1u);
    return b;
}
__device__ __forceinline__ void xcd_barrier_complete(unsigned* bar, unsigned x, unsigned& nloc, unsigned& nx) {
    const unsigned G = gridDim.x * gridDim.y * gridDim.z;
    unsigned sum, cnt, mine, sp = 0u;
    for (;;) {
        sum = 0u; cnt = 0u; mine = 0u;
#pragma unroll
        for (unsigned j = 0; j < 16; ++j) { const unsigned c = xb_ld(&bar[XB_XCNT(j)]); sum += c; cnt += (c > 0u) ? 1u : 0u; mine = (j == x) ? c : mine; }
        if (sum == G) break;
        __builtin_amdgcn_s_sleep(1);
        if ((++sp & 255u) == 0u) { if (xb_ld(&bar[XB_TMO])) break; if (sp > XB_SPIN_CAP) { atomicAdd(&bar[XB_TMO], 1u); break; } }
    }
    nloc = mine > 0u ? mine : 1u; nx = cnt > 0u ? cnt : 1u;
}

__device__ __forceinline__ void xcd_barrier(const XcdBarrier& b) {
    asm volatile("s_waitcnt vmcnt(0)" ::: "memory");
    __syncthreads();
    if (threadIdx.x == 0) {
        unsigned* bar = b.bar;
        __builtin_amdgcn_s_waitcnt(0);
        unsigned nloc = b.st[0], nx = b.st[1];
        if (nloc == 0u) { xcd_barrier_complete(bar, b.x, nloc, nx); b.st[0] = nloc; b.st[1] = nx; }
        const unsigned old = xb_add(&bar[XB_XSUB(b.x)], 1u);
        const unsigned gen = old / nloc;
        if (old + 1u == (gen + 1u) * nloc) {
            __builtin_amdgcn_fence(__ATOMIC_RELEASE, "agent");
            asm volatile("s_waitcnt vmcnt(0)" ::: "memory");
            const unsigned og = xb_add(&bar[XB_TOP], 1u);
            const unsigned tg = og / nx;
            if (og + 1u == (tg + 1u) * nx) xb_add(&bar[XB_TOPGEN], 1u);
            else XB_SPIN(xb_ld(&bar[XB_TOPGEN]) == tg, bar);
            __builtin_amdgcn_fence(__ATOMIC_ACQUIRE, "agent");
            xb_add(&bar[XB_XGEN(b.x)], 1u);
            asm volatile("s_waitcnt vmcnt(0)" ::: "memory");
        } else {
            XB_SPIN(xb_ld(&bar[XB_XGEN(b.x)]) == gen, bar);
            __builtin_amdgcn_fence(__ATOMIC_ACQUIRE, "agent");
            asm volatile("s_waitcnt vmcnt(0)" ::: "memory");
        }
    }
    __syncthreads();
}

__global__ void __launch_bounds__(512) mega_fwd(Args args) {
    extern __shared__ __attribute__((aligned(16))) unsigned char lds_raw[];
    LAS unsigned char* lds = (LAS unsigned char*)lds_raw;
    const int ph_lo = args.ph_lo, ph_hi = args.ph_hi;
    volatile LAS unsigned* bst = (volatile LAS unsigned*)(lds + 147456 + 64);
    if (threadIdx.x == 0) { bst[0] = 0u; bst[1] = 0u; }
    __syncthreads();
    if (ph_hi - ph_lo > 1) (void)xcd_barrier_post((unsigned*)(args.ws + WS_BAR), bst);

    constexpr int I_AB = 32 * (AB_IN / 32), I_C = 32 * (C_IN / 32), I_O = 32 * (DM / 32);
#define TR_LAYER(Lx, gwi, nwi) do { const int l2_ = (Lx) >> 1; LAS float* scr_ = (LAS float*)(lds + wave * 16384); \
        if ((Lx) & 1) { for (int it_ = (gwi); it_ < I_C + I_O; it_ += (nwi)) { \
            if (it_ < I_C) p0_transpose_item(ap->in[12] + (size_t)l2_ * DM * C_IN, ap->in[11] + l2_ * DM, DM, C_IN, (u16*)(ws + WS_WIN_C) + (size_t)l2_ * C_IN * DM, scr_, it_, lane); \
            else p0_transpose_item(ap->in[13] + (size_t)l2_ * DM * DM, nullptr, DM, DM, (u16*)(ws + WS_WOUT_C) + (size_t)l2_ * DM * DM, scr_, it_ - I_C, lane); } } \
        else { for (int it_ = (gwi); it_ < I_AB + I_O; it_ += (nwi)) { \
            if (it_ < I_AB) p0_transpose_item(ap->in[3] + (size_t)l2_ * DM * AB_IN, ap->in[2] + l2_ * DM, DM, AB_IN, (u16*)(ws + WS_WIN_AB) + (size_t)l2_ * AB_IN * DM, scr_, it_, lane); \
            else p0_transpose_item(ap->in[4] + (size_t)l2_ * DM * DM, nullptr, DM, DM, (u16*)(ws + WS_WOUT_AB) + (size_t)l2_ * DM * DM, scr_, it_ - I_AB, lane); } } } while (0)
#ifndef PROBE_SUB
#define PROBE_SUB -1
#endif
#ifndef PROBE_PAR
#define PROBE_PAR 2
#endif
    for (int ph = ph_lo; ph < ph_hi; ++ph) {
      const int nrep = (PROBE_SUB >= 0 && ph > 0 && (ph - 1) % 4 == PROBE_SUB && (PROBE_PAR == 2 || (((ph - 1) / 4) & 1) == PROBE_PAR)) ? 2 : ((PROBE_SUB == -2 && ph == 0) ? 2 : 1);
      for (int rep = 0; rep < nrep; ++rep) {
        typedef const __attribute__((address_space(4))) Args* kargs_t;
        kargs_t ap; { auto k = __builtin_amdgcn_kernarg_segment_ptr(); asm volatile("" : "+s"(k)); ap = (kargs_t)k; }
        int tid = threadIdx.x, G = gridDim.x, c = blockIdx.x; asm volatile("" : "+v"(tid), "+s"(G), "+s"(c));
        const int lane = tid & 63, wave = __builtin_amdgcn_readfirstlane(tid >> 6), gw = c * 8 + wave, ngw = G * 8;
        unsigned char* ws = ap->ws; float* out = ap->out;
        u16* H = (u16*)(ws + WS_H); u16* Y = (u16*)(ws + WS_Y); u16* Z = (u16*)(ws + WS_Z); u16* KV = (u16*)(ws + WS_KV); float* SSQ = (float*)(ws + WS_SSQ);
        const float* xs_off = ap->in[1] - (size_t)NTOK_P * DM;
        if (ph == 0) {
            TR_LAYER(0, gw, ngw);
            rope_tables(ws, c * 512 + tid, G * 512);
            for (int e = c * 512 + tid; e < 3 * MTOK; e += G * 512) SSQ[MTOK + e] = 0.f;
            cvt_phase(ap->in[0], xs_off, H, SSQ, gw, ngw, lane);
        } else {
            const int L = (ph - 1) / 4, sub = (ph - 1) % 4, li = L >> 1; const bool odd = (L & 1) != 0;
            if (sub == 0) {
#ifndef NO_GEMM_IN
                LAS float* rst = (LAS float*)(lds + 131072);
#define RST_FILL() do { const float* ssq_ = SSQ + L * MTOK; for (int i_ = 0; i_ < 16; ++i_) { pg8::Unit u_; if (!S.next(i_, u_)) break; \
                    if (tid < 256) rst[i_ * 256 + tid] = 1.0f / sqrtf(ssq_[u_.pm * 256 + tid] * (1.f / DM) + EPS); } __syncthreads(); } while (0)
                if (!odd) { pg8::Gemm g{H, (const u16*)(ws + WS_WIN_AB) + (size_t)li * AB_IN * DM, MTOK, AB_IN, DM}; pg8::StaticOrder S; S.init(MTOK, AB_IN, G, c);
                    RST_FILL(); pg8::EpiAct E{Z, AB_IN, 2048, 3072, 4608, KV, 4096, 4608, rst}; pg8::gemm_phase<pg8::EpiAct, pg8::StaticOrder, true, true>(lds, g, S, E); }
                else { pg8::Gemm g{H, (const u16*)(ws + WS_WIN_C) + (size_t)li * C_IN * DM, MTOK, C_IN, DM}; pg8::StaticOrder S; S.init(MTOK, C_IN, G, c);
                    RST_FILL(); pg8::EpiAct E{Z, C_IN, 0, 0, 3072, KV, 2048, 3072, rst}; pg8::gemm_phase<pg8::EpiAct, pg8::StaticOrder, true, true>(lds, g, S, E); }
                if (L < 3) { const int nwg_ = (MTOK / 256) * ((odd ? C_IN : AB_IN) / 256), nr_ = (nwg_ + G - 1) / G; int c0_ = nwg_ - (nr_ - 1) * G; if (c0_ >= G) c0_ = 0;
                    if (c >= c0_) TR_LAYER(L + 1, (c - c0_) * 8 + wave, (G - c0_) * 8); }
#endif
            } else if (sub == 1) {
                if (!odd) prep_phase<false>(KV, ap->in[9] + li * 128, ws, gw, ngw, lane);
                else prep_phase<true>(KV, ap->in[15] + li * 128, ws, gw, ngw, lane);
            } else if (sub == 2) {
                if (!odd) {
#ifndef NO_MIXB
                    {
                    for (int ub = c; ub < (MTOK / 128) * 4; ub += G) {
                        const int blk = ub >> 2, h0 = (ub & 3) * 2, kvh = h0 >> 2; int seq0, S_, i0;
                        if (blk < NTOK_P / 128) { seq0 = (blk / (SEQ_P / 128)) * SEQ_P; S_ = SEQ_P; i0 = (blk % (SEQ_P / 128)) * 128; }
                        else { const int r2 = blk - NTOK_P / 128; seq0 = NTOK_P + (r2 / (SEQ_S / 128)) * SEQ_S; S_ = SEQ_S; i0 = (r2 % (SEQ_S / 128)) * 128; }
                        const int k_lo = i0 >= 128 ? i0 - 128 : 0, k_hi = (i0 + 256 <= S_) ? i0 + 256 : S_, NT = (k_hi - k_lo) >> 6;
                        const u16* zq = Z + (size_t)(seq0 + i0) * AB_IN; const u16* kvp = KV + (size_t)(seq0 + k_lo) * 128;
                        const int un = ub + G; const bool hn = un < (MTOK / 128) * 4;
                        const u16* qnext = hn ? Z + (size_t)((un >> 2) * 128) * AB_IN + 3072 + ((un & 3) * 2) * 128 : nullptr;
                        att::attn_unit<true, AB_IN, 2>(zq + 3072 + h0 * 128, kvp + (size_t)kvh * MTOK * 128, kvp + (size_t)(2 + kvh) * MTOK * 128, zq + 4608 + h0 * 128,
                                                    Y + (size_t)(seq0 + i0) * DM + 1024 + h0 * 128, NT, ap->in[10] + li * 8 + h0, i0 - k_lo, (LAS char*)lds,
                                                    ap->in[8] + li * 128, (const f32x2*)(ws + WS_TABB), (const f32x2*)(ws + WS_TABB), i0);
                        __syncthreads();
                    } }
#endif
#ifndef NO_MIXA
                    mixer_a_phase(Z, Y, ap->in[5] + li * 1024, ap->in[6] + (size_t)li * 8 * 128 * 128, ap->in[7] + li * 1024, c, G, (LAS char*)lds);
#endif
                } else {
#ifndef NO_MIXC
                    const int nun = (G == 256) ? 10 : (2560 + G - 1) / G;
#define MC_UNIT(i_, ok_, b_, h_, qb_, samp_) do { ok_ = true; \
                        if (G == 256) { const int x_ = c & 7, l_ = c >> 3; \
                            if ((i_) < 8) { const int pair_ = 2 * x_ + ((i_) >> 2); b_ = pair_ >> 2; h_ = (pair_ & 3) * 4 + ((i_) & 3); qb_ = l_; samp_ = false; } \
                            else { const int pair_ = 2 * x_ + ((i_) - 8); b_ = pair_ >> 2; h_ = (pair_ & 3) * 4 + (l_ >> 3); qb_ = l_ & 7; samp_ = true; } \
                            if ((i_) >= 10) ok_ = false; \
                        } else { const int u_ = c + (i_) * G; if (u_ >= 2560) ok_ = false; \
                            if (u_ < 2048) { b_ = u_ >> 9; h_ = (u_ >> 5) & 15; qb_ = u_ & 31; samp_ = false; } else { const int v_ = u_ - 2048; b_ = v_ >> 7; h_ = (v_ >> 3) & 15; qb_ = v_ & 7; samp_ = true; } } } while (0)
                    {
                    for (int i = 0; i < nun; ++i) {
                        int b, h, qb; bool samp, ok; MC_UNIT(i, ok, b, h, qb, samp); if (!ok) break;
                        const int seq0 = samp ? NTOK_P + b * SEQ_S : b * SEQ_P, S_ = samp ? SEQ_S : SEQ_P, i0 = qb * 256;
                        const u16* zq = Z + (size_t)(seq0 + i0) * C_IN; const u16* kvp = KV + (size_t)seq0 * 128;
                        int bn, hn_, qbn; bool sampn, okn; MC_UNIT(i + 1, okn, bn, hn_, qbn, sampn); okn = okn && (i + 1 < nun);
                        const u16* qnext = okn ? Z + (size_t)((sampn ? NTOK_P + bn * SEQ_S : bn * SEQ_P) + qbn * 256) * C_IN + hn_ * 128 : nullptr;
                        att::attn_unit<false, C_IN, 2>(zq + h * 128, kvp + (size_t)(h >> 2) * MTOK * 128, kvp + (size_t)(4 + (h >> 2)) * MTOK * 128, zq + 3072 + h * 128,
                                                    Y + (size_t)(seq0 + i0) * DM + h * 128, S_ >> 6, nullptr, 0, (LAS char*)lds,
                                                    ap->in[14] + li * 128, (const f32x2*)(ws + WS_TABR), (const f32x2*)(ws + WS_TABC), i0);
                        __syncthreads();
                    } }
#undef MC_UNIT
#endif
                }
            } else {
#ifndef NO_GEMM_OUT
                const u16* wt = odd ? (const u16*)(ws + WS_WOUT_C) + (size_t)li * DM * DM : (const u16*)(ws + WS_WOUT_AB) + (size_t)li * DM * DM;
                pg8::Gemm g{Y, wt, MTOK, DM, DM}; pg8::StaticOrder S; S.init(MTOK, DM, G, c);
                pg8::EpiRes E{L == 0 ? ap->in[0] : nullptr, L == 0 ? xs_off : nullptr, H, L == 3 ? out : nullptr, DM, NTOK_P, L < 3 ? H : nullptr, SSQ + (L < 3 ? L + 1 : 0) * MTOK};
                pg8::gemm_phase<pg8::EpiRes, pg8::StaticOrder, true, true>(lds, g, S, E);
#endif
            }
        }
        if (ph + 1 < ph_hi || rep + 1 < nrep) {
            if (ph == ph_lo && rep == 0) cg::this_grid().sync();
            else { XcdBarrier xb; xb.bar = (unsigned*)(ap->ws + WS_BAR); xb.x = xb_xcc_id(); xb.st = bst; xcd_barrier(xb); }
        }
      }
    }
}

extern "C" void kernel_launch(void* const* d_in, const int* in_sizes, int n_in, void* d_out, int out_size, void* d_ws, size_t ws_size, hipStream_t stream) {
    static int grid = 0;
    if (grid == 0) {
        if (n_in != 16 || out_size != MTOK * DM || ws_size < WS_END) { fprintf(stderr, "kernel_launch: unexpected shapes: n_in %d out %d ws %zu (need %zu)\n", n_in, out_size, ws_size, (size_t)WS_END); grid = -1; return; }
        int dev = 0, cus = 0, per_cu = 0;
        if (hipGetDevice(&dev) != hipSuccess || hipDeviceGetAttribute(&cus, hipDeviceAttributeMultiprocessorCount, dev) != hipSuccess) { fprintf(stderr, "kernel_launch: device query failed\n"); grid = -1; return; }
        if (hipFuncSetAttribute((const void*)mega_fwd, hipFuncAttributeMaxDynamicSharedMemorySize, LDS_BYTES) != hipSuccess) { fprintf(stderr, "kernel_launch: hipFuncSetAttribute failed\n"); grid = -1; return; }
        if (hipOccupancyMaxActiveBlocksPerMultiprocessor(&per_cu, (const void*)mega_fwd, 512, LDS_BYTES) != hipSuccess || per_cu < 1) { fprintf(stderr, "kernel_launch: occupancy query gave %d\n", per_cu); (void)hipGetLastError(); per_cu = 1; }
        if (cus * 16 < (MTOK / 256) * (AB_IN / 256)) { fprintf(stderr, "kernel_launch: %d CUs: the in-projection phase would give a workgroup more than 16 units (its LDS table of row scales holds 16)\n", cus); grid = -1; return; }
        grid = cus * 1;
    }
    if (grid < 0) return;
    if (hipMemsetAsync((char*)d_ws + WS_BAR, 0, BAR_BYTES, stream) != hipSuccess) { fprintf(stderr, "kernel_launch: memset of the barrier words failed\n"); return; }
    Args a{};
    for (int i = 0; i < 16; ++i) a.in[i] = (const float*)d_in[i];
    a.out = (float*)d_out; a.ws = (unsigned char*)d_ws;
#if MK_MULTI
    for (int ph = 0; ph < NPHASE; ++ph) { a.ph_lo = ph; a.ph_hi = ph + 1;
        hipLaunchKernelGGL(mega_fwd, dim3(grid), dim3(512), LDS_BYTES, stream, a);
        const hipError_t le = hipPeekAtLastError(); if (le != hipSuccess) { fprintf(stderr, "kernel_launch: launch %d failed: %s\n", ph, hipGetErrorName(le)); break; } }
#else
    a.ph_lo = 0; a.ph_hi = NPHASE;
    void* kargs[] = {&a};
    const hipError_t le = hipLaunchCooperativeKernel((const void*)mega_fwd, dim3(grid), dim3(512), kargs, LDS_BYTES, stream);
    if (le != hipSuccess) fprintf(stderr, "kernel_launch: cooperative launch failed: %s (grid %d)\n", hipGetErrorString(le), grid);
#endif
}
```

```cpp
#include <hip/hip_runtime.h>
#include <hip/hip_cooperative_groups.h>
#include <cstdio>
#include <cstdint>
namespace cg = cooperative_groups;

#define LAS __attribute__((address_space(3)))
typedef unsigned short u16;
typedef _Float16 hx8 __attribute__((ext_vector_type(8)));
typedef _Float16 hx4 __attribute__((ext_vector_type(4)));
typedef _Float16 hx2 __attribute__((ext_vector_type(2)));
typedef short s16x4 __attribute__((ext_vector_type(4)));
typedef short s16x8 __attribute__((ext_vector_type(8)));
typedef float f32x2 __attribute__((ext_vector_type(2)));
typedef float f32x4 __attribute__((ext_vector_type(4)));
typedef float f32x16 __attribute__((ext_vector_type(16)));
typedef unsigned u32x2 __attribute__((ext_vector_type(2)));
typedef unsigned u32x4 __attribute__((ext_vector_type(4)));

constexpr int DM = 2048, SEQ_P = 8192, SEQ_S = 2048, NTOK_P = 4 * SEQ_P, NTOK_S = 4 * SEQ_S, MTOK = NTOK_P + NTOK_S;
constexpr int AB_IN = 5632, C_IN = 5120;
constexpr float EPS = 1e-6f;
#ifndef MK_MULTI
#define MK_MULTI 0
#endif

__device__ __forceinline__ unsigned pkh(float lo, float hi) { hx2 v = {(_Float16)lo, (_Float16)hi}; return __builtin_bit_cast(unsigned, v); }
__device__ __forceinline__ float h2f(u16 b) { return (float)__builtin_bit_cast(_Float16, b); }
__device__ __forceinline__ u16 f2h(float f) { return __builtin_bit_cast(u16, (_Float16)f); }
__device__ __forceinline__ float wave_sum(float v) {
#pragma unroll
    for (int o = 1; o < 64; o <<= 1) v += __shfl_xor(v, o);
    return v;
}
__device__ __forceinline__ float sigmoidf_fast(float t) { return __builtin_amdgcn_rcpf(1.0f + __expf(-t)); }
__device__ __forceinline__ float gelu_tanh(float v) { const float u = 0.7978845608028654f * (v + 0.044715f * v * v * v); return v * sigmoidf_fast(2.0f * u); }
__device__ __forceinline__ float silu_f(float v) { return v * sigmoidf_fast(v); }
__device__ __forceinline__ f32x2 act_tail2(f32x2 v, f32x2 a) { f32x2 ex; ex.x = __builtin_amdgcn_exp2f(a.x); ex.y = __builtin_amdgcn_exp2f(a.y); const f32x2 d = ex + 1.0f; f32x2 r; r.x = __builtin_amdgcn_rcpf(d.x); r.y = __builtin_amdgcn_rcpf(d.y); return v * r; }
__device__ __forceinline__ f32x2 gelu2(f32x2 v) { const f32x2 p = (v * v) * (-0.10294323970f) + (-2.30220819813f); return act_tail2(v, v * p); }
__device__ __forceinline__ f32x2 silu2(f32x2 v) { return act_tail2(v, v * (-1.4426950408889634f)); }
__device__ __forceinline__ f32x4 gelu4(f32x4 v) { const f32x2 a = gelu2((f32x2){v[0], v[1]}), b = gelu2((f32x2){v[2], v[3]}); return (f32x4){a.x, a.y, b.x, b.y}; }
__device__ __forceinline__ f32x4 silu4(f32x4 v) { const f32x2 a = silu2((f32x2){v[0], v[1]}), b = silu2((f32x2){v[2], v[3]}); return (f32x4){a.x, a.y, b.x, b.y}; }

namespace pg8 {
#define PG8_LAS __attribute__((address_space(3)))
typedef unsigned short bf16_t;
typedef _Float16 bf16x8 __attribute__((ext_vector_type(8)));
typedef float f32x4 __attribute__((ext_vector_type(4)));
typedef unsigned u32x4 __attribute__((ext_vector_type(4)));
constexpr int BM = 256, BK = 64, HALF = 128, HTB = HALF * BK * 2  , STAGE_BYTES = 8 * HTB, NXCD = 8, WGM = 8;

__host__ __device__ __forceinline__ int lds_byte(int r, int c) { const int st = (r >> 4) * 2 + (c >> 5), rr = r & 15, cc = c & 31, ob = rr * 64 + cc * 2; return st * 1024 + (ob ^ (((ob >> 9) & 1) << 5)); }
__host__ __device__ __forceinline__ void stage_rc(int b, int& R, int& C) { const int st = b / 1024, sb = b % 1024, swz = sb ^ (((sb >> 9) & 1) << 5); R = (st >> 1) * 16 + swz / 64; C = (st & 1) * 32 + (swz % 64) / 2; }
__host__ __device__ __forceinline__ int perm32(int rho) { const int n = rho >> 4, i = rho & 15; return 8 * (i >> 2) + 4 * n + (i & 3); }

struct Unit { int pm, pn, idx; };
struct Gemm { const bf16_t* A; const bf16_t* Bt; int M, N, K; };

struct StaticOrder {
    int nM, nN, nwg, G, c;
    __host__ __device__ void init(int M, int N, int G_, int c_) { nM = M / BM; nN = N / BM; nwg = nM * nN; G = G_; c = c_; }
    __host__ __device__ bool next(int i, Unit& u) const {
        const long L = (long)i * G + c; if (L >= nwg) return false;
        int wgid = (int)L; { const int q = nwg / NXCD, r = nwg % NXCD, xcd = wgid % NXCD, off = wgid / NXCD; wgid = (xcd < r ? xcd * (q + 1) : r * (q + 1) + (xcd - r) * q) + off; }
        const int nig = WGM * nN, gid = wgid / nig, fm = gid * WGM, gsz = (nM - fm) < WGM ? (nM - fm) : WGM;
        u.pm = fm + ((wgid % nig) % gsz); u.pn = (wgid % nig) / gsz; u.idx = i; return true;
    }
    __device__ __forceinline__ void a_ready(const Unit&) const {}
    __device__ __forceinline__ void done(const Unit&) const {}
};

struct EpiAct {
    static constexpr bool PERM = true, AFTER_DRAIN = false;
    u16* O; int ldc; int g_end, s_end, n_end; u16* KV; int kv_lo, kv_hi; const LAS float* rst;
    template <int ACT> __device__ __forceinline__ void run(const f32x4 (&acc)[2][2][4][2], const Unit& u, int wr, int wc, int fr, int fq) const {
        const int row0 = u.pm * BM + wr * 64 + fr, col0 = u.pn * BM + wc * 32 + 8 * fq;
#pragma unroll
        for (int ai = 0; ai < 2; ++ai)
#pragma unroll
            for (int m = 0; m < 4; ++m) { u16* rowp = O + (size_t)(row0 + ai * HALF + m * 16) * ldc + col0;
                const float rs = rst[u.idx * 256 + wr * 64 + fr + ai * HALF + m * 16];
#pragma unroll
                for (int bj = 0; bj < 2; ++bj) { f32x4 v0 = acc[ai][bj][m][0] * rs, v1 = acc[ai][bj][m][1] * rs;
                    if (ACT == 1) { v0 = gelu4(v0); v1 = gelu4(v1); }
                    if (ACT == 2) { v0 = silu4(v0); v1 = silu4(v1); }
                    u32x4 w; w.x = pkh(v0[0], v0[1]); w.y = pkh(v0[2], v0[3]); w.z = pkh(v1[0], v1[1]); w.w = pkh(v1[2], v1[3]);
                    __builtin_nontemporal_store(w, (u32x4*)(rowp + bj * HALF)); } }
    }
    __device__ __forceinline__ void run_kv(const f32x4 (&acc)[2][2][4][2], const Unit& u, int wr, int wc, int fr, int fq) const {
        const int row0 = u.pm * BM + wr * 64 + fr, slot0 = (u.pn * BM - kv_lo) >> 7;
#pragma unroll
        for (int ai = 0; ai < 2; ++ai)
#pragma unroll
            for (int m = 0; m < 4; ++m) { const float rs = rst[u.idx * 256 + wr * 64 + fr + ai * HALF + m * 16];
#pragma unroll
                for (int bj = 0; bj < 2; ++bj) { const f32x4 v0 = acc[ai][bj][m][0] * rs, v1 = acc[ai][bj][m][1] * rs;
                    u32x4 w; w.x = pkh(v0[0], v0[1]); w.y = pkh(v0[2], v0[3]); w.z = pkh(v1[0], v1[1]); w.w = pkh(v1[2], v1[3]);
                    *(u32x4*)(KV + ((size_t)(slot0 + bj) * MTOK + (row0 + ai * HALF + m * 16)) * 128 + wc * 32 + 8 * fq) = w; } }
    }
    __device__ __forceinline__ void operator()(const f32x4 (&acc)[2][2][4][2], const Unit& u, int wr, int wc, int fr, int fq) const {
        const int colt = u.pn * BM; if (colt >= kv_lo && colt < kv_hi) { run_kv(acc, u, wr, wc, fr, fq); return; }
        const int act = colt < g_end ? 1 : (colt < s_end ? 2 : (colt < n_end ? 0 : 2));
        if (act == 1) run<1>(acc, u, wr, wc, fr, fq); else if (act == 2) run<2>(acc, u, wr, wc, fr, fq); else run<0>(acc, u, wr, wc, fr, fq);
    }
};
struct EpiRes {
    static constexpr bool PERM = true, AFTER_DRAIN = false;
    const float* base0; const float* base1; const u16* Hb; float* out; int ldc; int split_row; u16* Hn; float* ssqn;
    __device__ __forceinline__ void operator()(const f32x4 (&acc)[2][2][4][2], const Unit& u, int wr, int wc, int fr, int fq) const {
        const int row0 = u.pm * BM + wr * 64 + fr, col0 = u.pn * BM + wc * 32 + 8 * fq;
        const float* base = (u.pm * BM < split_row) ? base0 : base1;
#pragma unroll
        for (int ai = 0; ai < 2; ++ai)
#pragma unroll
            for (int m = 0; m < 4; ++m) { const size_t off = (size_t)(row0 + ai * HALF + m * 16) * ldc + col0; float s = 0.f;
#pragma unroll
                for (int bj = 0; bj < 2; ++bj) { f32x4 b0, b1;
                    if (base0) { b0 = __builtin_nontemporal_load((const f32x4*)(base + off + bj * HALF)); b1 = __builtin_nontemporal_load((const f32x4*)(base + off + bj * HALF + 4)); }
                    else { const hx8 hb = *(const hx8*)(Hb + off + bj * HALF); b0 = (f32x4){(float)hb[0], (float)hb[1], (float)hb[2], (float)hb[3]}; b1 = (f32x4){(float)hb[4], (float)hb[5], (float)hb[6], (float)hb[7]}; }
                    const f32x4 x0 = b0 + acc[ai][bj][m][0], x1 = b1 + acc[ai][bj][m][1];
                    if (out) { __builtin_nontemporal_store(x0, (f32x4*)(out + off + bj * HALF)); __builtin_nontemporal_store(x1, (f32x4*)(out + off + bj * HALF + 4)); }
                    if (Hn) { *(u32x4*)(Hn + off + bj * HALF) = (u32x4){pkh(x0[0], x0[1]), pkh(x0[2], x0[3]), pkh(x1[0], x1[1]), pkh(x1[2], x1[3])};
                        s += ((x0[0] * x0[0] + x0[1] * x0[1]) + (x0[2] * x0[2] + x0[3] * x0[3])) + ((x1[0] * x1[0] + x1[1] * x1[1]) + (x1[2] * x1[2] + x1[3] * x1[3])); } }
                if (Hn) { s += __shfl_xor(s, 16); s += __shfl_xor(s, 32); if (fq == 0) atomicAdd(ssqn + row0 + ai * HALF + m * 16, s); } }
    }
};
template <class Epi, class Sched, bool ALIGN_EPI = false, bool SP2 = false>
__device__ __forceinline__ void gemm_phase(PG8_LAS unsigned char* lds, const Gemm g, const Sched& S, const Epi& E) {
    int tid = threadIdx.x; asm volatile("" : "+v"(tid));
    const int wid = __builtin_amdgcn_readfirstlane(tid >> 6), lane = tid & 63, wr = wid >> 2, wc = wid & 3, fr = lane & 15, fq = lane >> 4;
    const int K = g.K, nt = K / BK;
    unsigned voffA[2], voffB[2];
#pragma unroll
    for (int i = 0; i < 2; ++i) { int R, C; stage_rc(tid * 16 + i * 8192, R, C); const int Rb = Epi::PERM ? ((R & ~31) + perm32(R & 31)) : R;
        voffA[i] = (unsigned)(R * K + C) * 2u; voffB[i] = (unsigned)(Rb * K + C) * 2u; }
    const size_t kstep = (size_t)(BK * 2);
    const size_t hstep = (size_t)HALF * K * 2;
    const size_t tstep = 2 * hstep;
    const unsigned ldsw = (unsigned)wid * 1024u;
    const int aoff = lds_byte(wr * 64 + fr, fq * 8), boff = lds_byte(wc * 32 + fr, fq * 8);
#define PG8_SA(b, h) (((b) * 2 + (h)) * HTB)
#define PG8_SB(b, h) ((4 + (b) * 2 + (h)) * HTB)
#define PG8_STAGE(bufoff, gbase, voff) do { _Pragma("unroll") for (int _i = 0; _i < 2; ++_i) \
        __builtin_amdgcn_global_load_lds((const unsigned*)((const char*)(gbase) + (voff)[_i]), (PG8_LAS unsigned*)(lds + (bufoff) + ldsw + _i * 8192), 16, 0, 0); } while (0)
#define PG8_LDA(dst, b, h) do { _Pragma("unroll") for (int m = 0; m < 4; ++m) _Pragma("unroll") for (int k = 0; k < 2; ++k) dst[m][k] = *(const PG8_LAS bf16x8*)(lds + PG8_SA(b, h) + aoff + m * 2048 + k * 1024); } while (0)
#define PG8_LDB(dst, b, h) do { _Pragma("unroll") for (int n = 0; n < 2; ++n) _Pragma("unroll") for (int k = 0; k < 2; ++k) dst[n][k] = *(const PG8_LAS bf16x8*)(lds + PG8_SB(b, h) + boff + n * 2048 + k * 1024); } while (0)
#define PG8_MMA(ai, bj, At, Bt) do { __builtin_amdgcn_s_setprio(1); _Pragma("unroll") for (int m = 0; m < 4; ++m) _Pragma("unroll") for (int n = 0; n < 2; ++n) _Pragma("unroll") for (int k = 0; k < 2; ++k) \
        acc[ai][bj][m][n] = __builtin_amdgcn_mfma_f32_16x16x32_f16(Bt[n][k], At[m][k], acc[ai][bj][m][n], 0, 0, 0); __builtin_amdgcn_s_setprio(0); } while (0)
#define PG8_WAIT_V(n) asm volatile("s_waitcnt vmcnt(" #n ")" ::: "memory")
#define PG8_WAIT_L(n) asm volatile("s_waitcnt lgkmcnt(" #n ")" ::: "memory")
#define PG8_BAR __builtin_amdgcn_s_barrier()
#define PG8_SCHED __builtin_amdgcn_sched_barrier(0)
    Unit cur, nxt; int ui = 0;
    if (!S.next(0, cur)) return;
    f32x4 acc[2][2][4][2];
#pragma unroll
    for (int a = 0; a < 2; ++a)
#pragma unroll
        for (int b = 0; b < 2; ++b)
#pragma unroll
            for (int m = 0; m < 4; ++m)
#pragma unroll
                for (int n = 0; n < 2; ++n) acc[a][b][m][n] = (f32x4){0.f, 0.f, 0.f, 0.f};
    bf16x8 At[4][2], B0[2][2], B1[2][2];
    const char* cA = (const char*)g.A + (size_t)cur.pm * tstep; const char* cB = (const char*)g.Bt + (size_t)cur.pn * tstep;
    S.a_ready(cur);
    if constexpr (SP2) {
        PG8_STAGE(PG8_SB(0, 0), cB, voffB); PG8_STAGE(PG8_SB(0, 1), cB + hstep, voffB); PG8_STAGE(PG8_SA(0, 0), cA, voffA); PG8_STAGE(PG8_SA(0, 1), cA + hstep, voffA);
        if (wr == 1) PG8_BAR;
        PG8_WAIT_V(2); PG8_BAR;
        PG8_STAGE(PG8_SB(1, 0), cB + kstep, voffB); PG8_STAGE(PG8_SA(1, 0), cA + kstep, voffA); PG8_STAGE(PG8_SB(1, 1), cB + hstep + kstep, voffB);
        PG8_WAIT_V(6); PG8_BAR;
    } else {
        PG8_STAGE(PG8_SB(0, 0), cB, voffB); PG8_STAGE(PG8_SA(0, 0), cA, voffA); PG8_STAGE(PG8_SB(0, 1), cB + hstep, voffB); PG8_STAGE(PG8_SA(0, 1), cA + hstep, voffA);
        if (wr == 1) PG8_BAR;
        PG8_WAIT_V(4); PG8_BAR;
        PG8_STAGE(PG8_SB(1, 0), cB + kstep, voffB); PG8_STAGE(PG8_SA(1, 0), cA + kstep, voffA); PG8_STAGE(PG8_SB(1, 1), cB + hstep + kstep, voffB);
        PG8_WAIT_V(6); PG8_BAR;
    }
    for (;;) {
        const bool has_next = S.next(ui + 1, nxt);
        const char* nA = has_next ? (const char*)g.A + (size_t)nxt.pm * tstep : cA; const char* nB = has_next ? (const char*)g.Bt + (size_t)nxt.pn * tstep : cB;
        for (int t = 0; t < nt; t += 2) {
            const bool last = (t == nt - 2);
            const char* a1 = cA + (size_t)(t + 1) * kstep;
            const char* a2 = last ? nA : cA + (size_t)(t + 2) * kstep; const char* b2 = last ? nB : cB + (size_t)(t + 2) * kstep;
            const char* a3 = a2 + kstep; const char* b3 = b2 + kstep;
            if (last && has_next) S.a_ready(nxt);
            if constexpr (SP2) {
            PG8_LDB(B0, 0, 0); PG8_LDB(B1, 0, 1); PG8_SCHED; PG8_LDA(At, 0, 0); PG8_STAGE(PG8_SA(1, 1), a1 + hstep, voffA);
            PG8_WAIT_V(8); PG8_WAIT_L(0); PG8_BAR; PG8_MMA(0, 0, At, B0); PG8_MMA(0, 1, At, B1); PG8_BAR; PG8_SCHED;
            PG8_LDA(At, 0, 1); PG8_STAGE(PG8_SB(0, 0), b2, voffB); PG8_STAGE(PG8_SB(0, 1), b2 + hstep, voffB); PG8_STAGE(PG8_SA(0, 0), a2, voffA);
            PG8_WAIT_V(8); PG8_WAIT_L(0); PG8_BAR; PG8_MMA(1, 0, At, B0); PG8_MMA(1, 1, At, B1); PG8_BAR; PG8_SCHED;
            PG8_LDB(B0, 1, 0); PG8_LDB(B1, 1, 1); PG8_SCHED; PG8_LDA(At, 1, 0); PG8_STAGE(PG8_SA(0, 1), a2 + hstep, voffA);
            PG8_WAIT_V(8); PG8_WAIT_L(0); PG8_BAR; PG8_MMA(0, 0, At, B0); PG8_MMA(0, 1, At, B1); PG8_BAR; PG8_SCHED;
            PG8_LDA(At, 1, 1); PG8_STAGE(PG8_SB(1, 0), b3, voffB); PG8_STAGE(PG8_SB(1, 1), b3 + hstep, voffB); PG8_STAGE(PG8_SA(1, 0), a3, voffA);
            PG8_WAIT_V(8); PG8_WAIT_L(0); PG8_BAR; PG8_MMA(1, 0, At, B0); PG8_MMA(1, 1, At, B1); PG8_BAR; PG8_SCHED;
            } else {
            PG8_LDB(B0, 0, 0); PG8_SCHED; PG8_LDA(At, 0, 0); PG8_STAGE(PG8_SA(1, 1), a1 + hstep, voffA);
            PG8_WAIT_L(8); PG8_BAR; PG8_WAIT_L(0); PG8_MMA(0, 0, At, B0); PG8_BAR; PG8_SCHED;
            PG8_LDB(B1, 0, 1); PG8_STAGE(PG8_SB(0, 0), b2, voffB);
            PG8_BAR; PG8_WAIT_L(0); PG8_MMA(0, 1, At, B1); PG8_BAR;
            PG8_LDA(At, 0, 1); PG8_STAGE(PG8_SA(0, 0), a2, voffA);
            PG8_BAR; PG8_WAIT_L(0); PG8_MMA(1, 0, At, B0); PG8_BAR; PG8_SCHED;
            PG8_STAGE(PG8_SB(0, 1), b2 + hstep, voffB);
            PG8_WAIT_V(6); PG8_BAR; PG8_MMA(1, 1, At, B1); PG8_BAR;
            PG8_LDB(B0, 1, 0); PG8_SCHED; PG8_LDA(At, 1, 0); PG8_STAGE(PG8_SA(0, 1), a2 + hstep, voffA);
            PG8_WAIT_L(8); PG8_BAR; PG8_WAIT_L(0); PG8_MMA(0, 0, At, B0); PG8_BAR; PG8_SCHED;
            PG8_LDB(B1, 1, 1); PG8_STAGE(PG8_SB(1, 0), b3, voffB);
            PG8_BAR; PG8_WAIT_L(0); PG8_MMA(0, 1, At, B1); PG8_BAR;
            PG8_LDA(At, 1, 1); PG8_STAGE(PG8_SA(1, 0), a3, voffA);
            PG8_BAR; PG8_WAIT_L(0); PG8_MMA(1, 0, At, B0); PG8_BAR; PG8_SCHED;
            PG8_STAGE(PG8_SB(1, 1), b3 + hstep, voffB);
            PG8_WAIT_V(6); PG8_BAR; PG8_MMA(1, 1, At, B1); PG8_BAR;
            }
        }
        if constexpr (ALIGN_EPI) { if (wr == 0) PG8_BAR; }
        if constexpr (!Epi::AFTER_DRAIN) { E(acc, cur, wr, wc, fr, fq); S.done(cur); }
        if (!has_next) break;
#pragma unroll
        for (int a = 0; a < 2; ++a)
#pragma unroll
            for (int b = 0; b < 2; ++b)
#pragma unroll
                for (int m = 0; m < 4; ++m)
#pragma unroll
                    for (int n = 0; n < 2; ++n) acc[a][b][m][n] = (f32x4){0.f, 0.f, 0.f, 0.f};
        cur = nxt; cA = nA; cB = nB; ++ui;
        if constexpr (ALIGN_EPI) { if (wr == 1) PG8_BAR; }
    }
    PG8_WAIT_V(0);
    if constexpr (!ALIGN_EPI) { if (wr == 0) PG8_BAR; }
    PG8_BAR;
    if constexpr (Epi::AFTER_DRAIN) { E.fused(acc, cur, wr, wc, fr, fq, lds, wid, lane); S.done(cur); }
#undef PG8_SA
#undef PG8_SB
#undef PG8_STAGE
#undef PG8_LDA
#undef PG8_LDB
#undef PG8_MMA
#undef PG8_WAIT_V
#undef PG8_WAIT_L
#undef PG8_BAR
#undef PG8_SCHED
}
}
namespace att {
constexpr int D = 128, NW = 8, QBLK = 32, KVBLK = 64;
constexpr float SCALE = 0.088388347648318440f;
constexpr float THR = 8.f;
constexpr int SHM_V = KVBLK * D * 2, SHM_K = KVBLK * D * 2, SHM_ATTN = 2 * SHM_V + 2 * SHM_K + NW * 64 * 4;
#define KSWZ(row, colB) ((row) * 256 + ((colB) ^ (((row) & 7) << 4)))
#define SBAR() __builtin_amdgcn_sched_barrier(0)
__device__ __forceinline__ int crow(int r, int hi) { return (r & 3) + 8 * (r >> 2) + 4 * hi; }

__device__ __forceinline__ void partialSM(f32x16& p0, f32x16& p1, float& m_reg, float& mn, float& alpha) {
  constexpr float C = SCALE * 1.4426950408889634f;
  float pmax = p0[0];
#pragma unroll
  for (int r = 1; r < 16; ++r) pmax = fmaxf(pmax, p0[r]);
#pragma unroll
  for (int r = 0; r < 16; ++r) pmax = fmaxf(pmax, p1[r]);
  { auto rr = __builtin_amdgcn_permlane32_swap(__float_as_uint(pmax), __float_as_uint(pmax), false, false);
    pmax = fmaxf(__uint_as_float(rr[0]), __uint_as_float(rr[1])); }
  if (__builtin_expect(__all(pmax - m_reg <= THR / SCALE), 1)) { mn = m_reg; alpha = 1.f; }
  else { mn = fmaxf(m_reg, pmax); alpha = __builtin_amdgcn_exp2f((m_reg - mn) * C); m_reg = mn; }
  float mnC = -mn * C;
#pragma unroll
  for (int r = 0; r < 16; ++r) p0[r] = fmaf(p0[r], C, mnC);
#pragma unroll
  for (int r = 0; r < 16; ++r) p1[r] = fmaf(p1[r], C, mnC);
#pragma unroll
  for (int r = 0; r < 16; ++r) p0[r] = __builtin_amdgcn_exp2f(p0[r]);
}
__device__ __forceinline__ void finishSM(f32x16& p0, f32x16& p1, float alpha, float& l_reg, hx8& pa0, hx8& pa1, hx8& pa2, hx8& pa3) {
#pragma unroll
  for (int r = 0; r < 16; ++r) p1[r] = __builtin_amdgcn_exp2f(p1[r]);
  float ps = 0;
#pragma unroll
  for (int r = 0; r < 16; ++r) ps += p0[r];
#pragma unroll
  for (int r = 0; r < 16; ++r) ps += p1[r];
  { auto rr = __builtin_amdgcn_permlane32_swap(__float_as_uint(ps), __float_as_uint(ps), false, false);
    ps = __uint_as_float(rr[0]) + __uint_as_float(rr[1]); }
  l_reg = l_reg * alpha + ps;
#define PK4(P, BASE, OUT) do { unsigned a0 = pkh(P[BASE + 0], P[BASE + 1]), a1 = pkh(P[BASE + 2], P[BASE + 3]);   \
    unsigned b0 = pkh(P[BASE + 4], P[BASE + 5]), b1 = pkh(P[BASE + 6], P[BASE + 7]);                              \
    auto r0 = __builtin_amdgcn_permlane32_swap(a0, b0, false, false); auto r1 = __builtin_amdgcn_permlane32_swap(a1, b1, false, false); \
    u32x4 w = {r0[0], r1[0], r0[1], r1[1]}; OUT = __builtin_bit_cast(hx8, w); } while (0)
  PK4(p0, 0, pa0); PK4(p0, 8, pa1); PK4(p1, 0, pa2); PK4(p1, 8, pa3);
#undef PK4
}
template <bool QLDS>
__device__ __forceinline__ void qkt(f32x16& p0, f32x16& p1, const LAS char* Ks, const hx8* qr, const LAS char* qlds, int r32, int hi) {
  p0 = f32x16{}; p1 = f32x16{};
  const int B = (r32 * 256 + ((hi * 16) ^ ((r32 & 1) << 4))) | (((r32 >> 1) & 3) << 5);
#pragma unroll
  for (int d0 = 0; d0 < 8; ++d0) { const LAS char* kp = Ks + (B ^ ((d0 & 3) << 5)) + (d0 >> 2) * 128;
    hx8 b0 = *(const LAS hx8*)kp;
    hx8 b1 = *(const LAS hx8*)(kp + 8192);
    const hx8 q = QLDS ? *(const LAS hx8*)(qlds + d0 * 1024) : qr[d0];
    p0 = __builtin_amdgcn_mfma_f32_32x32x16_f16(b0, q, p0, 0, 0, 0);
    p1 = __builtin_amdgcn_mfma_f32_32x32x16_f16(b1, q, p1, 0, 0, 0); }
}
__device__ __forceinline__ void wmask(f32x16& p0, f32x16& p1, int dq, int hi) {
#pragma unroll
  for (int r = 0; r < 16; ++r) { const int d0 = dq - crow(r, hi), d1 = d0 - 32;
    if (d0 > 128 || d0 < -128) p0[r] = -1e30f;
    if (d1 > 128 || d1 < -128) p1[r] = -1e30f; }
}
__device__ __forceinline__ int v_st(int k, int c) { const int kk = (k & ~0xC) | ((k & 4) << 1) | ((k & 8) >> 1); return ((kk >> 3) * 4 + (c >> 5)) * 512 + ((kk & 7) * 32 + (c & 31)) * 2; }
__device__ __forceinline__ int v_rd_base(int lane) { return ((lane & 3) << 3) | (((lane >> 2) & 3) << 6) | (((lane >> 4) & 1) << 5) | (((lane >> 5) & 1) << 8); }
constexpr int v_rd_off(int d0, int ks, int half) { return d0 * 512 + ks * 4096 + half * 2048; }
template <int OFF> __device__ __forceinline__ s16x4 tr_read(int vb) {
  s16x4 r; asm volatile("ds_read_b64_tr_b16 %0, %1 offset:%2" : "=&v"(r) : "v"(vb), "i"(OFF) : "memory"); return r;
}
template <int D0> __device__ __forceinline__ void pv_one(f32x16& od, int vb, hx8 pa0, hx8 pa1, hx8 pa2, hx8 pa3) {
  const s16x4 l0 = tr_read<v_rd_off(D0, 0, 0)>(vb), h0 = tr_read<v_rd_off(D0, 0, 1)>(vb), l1 = tr_read<v_rd_off(D0, 1, 0)>(vb), h1 = tr_read<v_rd_off(D0, 1, 1)>(vb);
  const s16x4 l2 = tr_read<v_rd_off(D0, 2, 0)>(vb), h2 = tr_read<v_rd_off(D0, 2, 1)>(vb), l3 = tr_read<v_rd_off(D0, 3, 0)>(vb), h3 = tr_read<v_rd_off(D0, 3, 1)>(vb);
  asm volatile("s_waitcnt lgkmcnt(0)" ::: "memory"); SBAR();
#define PK(L, H) __builtin_bit_cast(hx8, (s16x8){L[0], L[1], L[2], L[3], H[0], H[1], H[2], H[3]})
  od = __builtin_amdgcn_mfma_f32_32x32x16_f16(pa0, PK(l0, h0), od, 0, 0, 0);
  od = __builtin_amdgcn_mfma_f32_32x32x16_f16(pa1, PK(l1, h1), od, 0, 0, 0);
  od = __builtin_amdgcn_mfma_f32_32x32x16_f16(pa2, PK(l2, h2), od, 0, 0, 0);
  od = __builtin_amdgcn_mfma_f32_32x32x16_f16(pa3, PK(l3, h3), od, 0, 0, 0);
#undef PK
}
__device__ __forceinline__ void pv_d0(f32x16* o, int vb, hx8 pa0, hx8 pa1, hx8 pa2, hx8 pa3) {
  pv_one<0>(o[0], vb, pa0, pa1, pa2, pa3); pv_one<1>(o[1], vb, pa0, pa1, pa2, pa3); pv_one<2>(o[2], vb, pa0, pa1, pa2, pa3); pv_one<3>(o[3], vb, pa0, pa1, pa2, pa3);
}

template <bool WIN, int LD, int SD>
__device__ __forceinline__ void attn_unit(const u16* __restrict__ Qb, const u16* __restrict__ Kh, const u16* __restrict__ Vh, const u16* __restrict__ Gb,
                                          u16* __restrict__ Yb, int NT, const float* __restrict__ sinkp, int dq0, LAS char* lds,
                                          const float* __restrict__ qn, const f32x2* __restrict__ tabA, const f32x2* __restrict__ tabB_, int t0) {
  constexpr int LDK = 128;
  int tid = threadIdx.x; asm volatile("" : "+v"(tid));
  const int wid = tid >> 6, lane = tid & 63, r32 = lane & 31, hi = lane >> 5;
  LAS char* V_lds = lds; LAS char* K_lds = lds + 2 * SHM_V;
  LAS float* ws = (LAS float*)(lds + 2 * SHM_V + 2 * SHM_K) + wid * 64; LAS float* li_l = ws; LAS float* al_l = ws + 32;
  const int wrow = WIN ? (wid & 3) * QBLK : wid * QBLK, hcol = WIN ? (wid >> 2) * 128 : 0;
  LAS char* qlds = lds + SHM_ATTN + wid * 8192 + lane * 16;
  float m_reg = WIN ? sinkp[wid >> 2] * (1.0f / SCALE) : -1e30f, l_reg = WIN ? 1.0f : 0.f; f32x16 o[4] = {}; hx8 qr[8];
  const u16* Qw = Qb + hcol + (long)(wrow + r32) * LD + hi * 8;
  const int sr = tid >> 4, sc = (tid & 15) * 8, vst0 = v_st(sr, sc), ksw0 = KSWZ(sr, sc * 2);
  const int vb0 = (int)(uintptr_t)V_lds + v_rd_base(lane);
  const int dqw = dq0 + wrow + r32;
  struct { hx8 vs0, vs1, ks0, ks1; } sr_[SD];
#define SLOAD(i, k0) do { sr_[i].vs0 = *(const hx8*)(&Vh[(long)((k0) + sr) * LDK + sc]); sr_[i].vs1 = *(const hx8*)(&Vh[(long)((k0) + 32 + sr) * LDK + sc]); \
    sr_[i].ks0 = *(const hx8*)(&Kh[(long)((k0) + sr) * LDK + sc]); sr_[i].ks1 = *(const hx8*)(&Kh[(long)((k0) + 32 + sr) * LDK + sc]); } while (0)
#define SWRITE(b, i) do { *(LAS hx8*)(V_lds + (b) * SHM_V + vst0) = sr_[i].vs0;          \
    *(LAS hx8*)(V_lds + (b) * SHM_V + vst0 + 8192) = sr_[i].vs1;                          \
    *(LAS hx8*)(K_lds + (b) * SHM_K + ksw0) = sr_[i].ks0;                                \
    *(LAS hx8*)(K_lds + (b) * SHM_K + ksw0 + 8192) = sr_[i].ks1; } while (0)
#define SWAIT() do { if (SD == 2) asm volatile("s_waitcnt vmcnt(4)" ::: "memory"); else asm volatile("s_waitcnt vmcnt(0)" ::: "memory"); } while (0)
#define RESC(a) do { if (__any((a) < 1.f)) { if (hi == 0) al_l[r32] = (a); asm volatile("s_waitcnt lgkmcnt(0)" ::: "memory"); \
    _Pragma("unroll") for (int d = 0; d < 4; ++d) _Pragma("unroll") for (int r = 0; r < 16; ++r) o[d][r] *= al_l[crow(r, hi)]; } } while (0)
  constexpr int SE = 0, SO = SD - 1;
  SLOAD(SE, 0);
  {
    float y[8][8]; float ss = 0.f;
#pragma unroll
    for (int d0 = 0; d0 < 8; ++d0) { const hx8 v = *(const hx8*)(Qw + d0 * 16);
#pragma unroll
      for (int j = 0; j < 8; ++j) { y[d0][j] = (float)v[j]; ss += y[d0][j] * y[d0][j]; } }
    { auto rr = __builtin_amdgcn_permlane32_swap(__float_as_uint(ss), __float_as_uint(ss), false, false); ss = __uint_as_float(rr[0]) + __uint_as_float(rr[1]); }
    const float rstd = 1.0f / sqrtf(ss * (1.f / 128.f) + 1e-6f);
#pragma unroll
    for (int d0 = 0; d0 < 8; ++d0) { const f32x4 g0 = *(const f32x4*)(qn + d0 * 16 + hi * 8), g1 = *(const f32x4*)(qn + d0 * 16 + hi * 8 + 4);
#pragma unroll
      for (int j = 0; j < 4; ++j) { y[d0][j] *= rstd * g0[j]; y[d0][4 + j] *= rstd * g1[j]; } }
    const int t = t0 + wrow + r32;
    if (WIN) {
      const f32x4* tp = (const f32x4*)(tabA + t * 16 + hi * 8);
#pragma unroll
      for (int j2 = 0; j2 < 4; ++j2) { const f32x4 cs = tp[j2];
        { const float x1 = y[0][2 * j2], x2 = y[1][2 * j2]; y[0][2 * j2] = x1 * cs.x - x2 * cs.y; y[1][2 * j2] = x2 * cs.x + x1 * cs.y; }
        { const float x1 = y[0][2 * j2 + 1], x2 = y[1][2 * j2 + 1]; y[0][2 * j2 + 1] = x1 * cs.z - x2 * cs.w; y[1][2 * j2 + 1] = x2 * cs.z + x1 * cs.w; } }
    } else {
#pragma unroll
      for (int hf = 0; hf < 2; ++hf)
#pragma unroll
        for (int dd = 0; dd < 2; ++dd) { const int da = hf * 4 + dd, db = da + 2;
          const f32x4* tp = (const f32x4*)((hf == 0 ? tabA + (t >> 6) * 32 : tabB_ + (t & 63) * 32) + dd * 16 + hi * 8);
#pragma unroll
          for (int j2 = 0; j2 < 4; ++j2) { const f32x4 cs = tp[j2];
            { const float x1 = y[da][2 * j2], x2 = y[db][2 * j2]; y[da][2 * j2] = x1 * cs.x - x2 * cs.y; y[db][2 * j2] = x2 * cs.x + x1 * cs.y; }
            { const float x1 = y[da][2 * j2 + 1], x2 = y[db][2 * j2 + 1]; y[da][2 * j2 + 1] = x1 * cs.z - x2 * cs.w; y[db][2 * j2 + 1] = x2 * cs.z + x1 * cs.w; } } }
    }
#pragma unroll
    for (int d0 = 0; d0 < 8; ++d0) { u32x4 w = {pkh(y[d0][0], y[d0][1]), pkh(y[d0][2], y[d0][3]), pkh(y[d0][4], y[d0][5]), pkh(y[d0][6], y[d0][7])}; qr[d0] = __builtin_bit_cast(hx8, w);
      if (WIN) *(LAS hx8*)(qlds + d0 * 1024) = qr[d0]; }
  }
  f32x16 pA0, pA1, pB0, pB1; float mnA, mnB, alA, alB; hx8 pa0, pa1, pa2, pa3;
  asm volatile("s_waitcnt vmcnt(0)" ::: "memory"); SWRITE(0, SE); __syncthreads();
  qkt<WIN>(pA0, pA1, K_lds, qr, qlds, r32, hi); if (WIN) wmask(pA0, pA1, dqw, hi); partialSM(pA0, pA1, m_reg, mnA, alA);
  SLOAD(SO, KVBLK); if (SD == 2) { if (2 < NT) SLOAD(SE, 2 * KVBLK); }
  SWAIT(); SWRITE(1, SO); __syncthreads();
  for (int j = 1; j + 1 < NT; j += 2) {
    SBAR(); qkt<WIN>(pB0, pB1, K_lds + SHM_K, qr, qlds, r32, hi); if (WIN) wmask(pB0, pB1, dqw - j * KVBLK, hi);
    finishSM(pA0, pA1, alA, l_reg, pa0, pa1, pa2, pa3); SBAR();
    SLOAD(SO, (j + SD) * KVBLK); SBAR();
    pv_d0(o, vb0, pa0, pa1, pa2, pa3); partialSM(pB0, pB1, m_reg, mnB, alB);
    __syncthreads(); SWAIT(); SWRITE(0, SE);
    RESC(alB); __syncthreads();
    SBAR(); qkt<WIN>(pA0, pA1, K_lds, qr, qlds, r32, hi); if (WIN) wmask(pA0, pA1, dqw - (j + 1) * KVBLK, hi);
    finishSM(pB0, pB1, alB, l_reg, pa0, pa1, pa2, pa3); SBAR();
    if (SD == 1 || j + 3 < NT) SLOAD(SE, (j + 1 + SD) * KVBLK); SBAR();
    pv_d0(o, vb0 + SHM_V, pa0, pa1, pa2, pa3); partialSM(pA0, pA1, m_reg, mnA, alA);
    __syncthreads(); SWAIT(); SWRITE(1, SO);
    RESC(alA); __syncthreads();
  }
  const u16* Gw = Gb + hcol + (long)wrow * LD; const int erow = lane >> 4, ech = (lane & 15) * 8;
  hx8 gpre[8];
#pragma unroll
  for (int it = 0; it < 8; ++it) gpre[it] = *(const hx8*)(Gw + (long)(it * 4 + erow) * LD + ech);
  SBAR(); qkt<WIN>(pB0, pB1, K_lds + SHM_K, qr, qlds, r32, hi); if (WIN) wmask(pB0, pB1, dqw - (NT - 1) * KVBLK, hi);
  finishSM(pA0, pA1, alA, l_reg, pa0, pa1, pa2, pa3); SBAR();
  pv_d0(o, vb0, pa0, pa1, pa2, pa3); partialSM(pB0, pB1, m_reg, mnB, alB);
  __syncthreads(); RESC(alB);
  finishSM(pB0, pB1, alB, l_reg, pa0, pa1, pa2, pa3); SBAR();
  pv_d0(o, vb0 + SHM_V, pa0, pa1, pa2, pa3);
  if (hi == 0) li_l[r32] = l_reg; asm volatile("s_waitcnt lgkmcnt(0)" ::: "memory");
  float rli[16];
#pragma unroll
  for (int r = 0; r < 16; ++r) rli[r] = __builtin_amdgcn_rcpf(li_l[crow(r, hi)]);
  LAS u16* img = (LAS u16*)(lds + SHM_ATTN + wid * 8192);
#pragma unroll
  for (int r = 0; r < 16; ++r) { const int orow = crow(r, hi);
#pragma unroll
    for (int d0 = 0; d0 < 4; ++d0) img[orow * 128 + d0 * 32 + r32] = f2h(o[d0][r] * rli[r]); }
  u16* Yw = Yb + hcol + (long)wrow * DM;
#pragma unroll
  for (int it = 0; it < 8; ++it) { const int row = it * 4 + erow;
    const hx8 ov = *(const LAS hx8*)(img + row * 128 + ech), gv = gpre[it];
    u32x4 w = {pkh((float)ov[0] * (float)gv[0], (float)ov[1] * (float)gv[1]), pkh((float)ov[2] * (float)gv[2], (float)ov[3] * (float)gv[3]),
               pkh((float)ov[4] * (float)gv[4], (float)ov[5] * (float)gv[5]), pkh((float)ov[6] * (float)gv[6], (float)ov[7] * (float)gv[7])};
    *(u32x4*)(Yw + (long)row * DM + ech) = w; }
#undef SLOAD
#undef SWRITE
#undef SWAIT
#undef RESC
}
}

constexpr size_t MiB = 1u << 20;
constexpr size_t WS_WIN_AB = 0, WS_WOUT_AB = 44 * MiB, WS_WIN_C = 60 * MiB, WS_WOUT_C = 100 * MiB, WS_TAB = 116 * MiB;
constexpr size_t WS_BAR = WS_TAB + 1 * MiB + 64 * 1024, BAR_BYTES = 16384;
constexpr size_t WS_SSQ = WS_TAB + 1 * MiB + 256 * 1024;
constexpr size_t WS_TABB = WS_TAB, WS_TABR = WS_TAB + 1 * MiB, WS_TABC = WS_TABR + 32768;
constexpr size_t WS_H = 118 * MiB, WS_Y = 278 * MiB, WS_Z = 438 * MiB, WS_KV = 878 * MiB, WS_END = 962 * MiB;
static_assert((size_t)2 * AB_IN * DM * 2 <= 44 * MiB && (size_t)2 * C_IN * DM * 2 <= 40 * MiB && (size_t)MTOK * DM * 2 <= 160 * MiB && (size_t)MTOK * AB_IN * 2 <= 440 * MiB, "ws map");
constexpr int LDS_BYTES = 151552;
constexpr int NPHASE = 17;

struct Args { const float* in[16]; float* out; unsigned char* ws; int ph_lo, ph_hi; };

__device__ __forceinline__ void p0_transpose_item(const float* W, const float* gain, int K, int N, u16* WT, LAS float* scr, int item, int lane) {
    const int nblk = N / 32, kb = item / nblk, nb = item % nblk, k0 = 64 * kb, n0 = 32 * nb;
    float wv[32];
#pragma unroll
    for (int i = 0; i < 32; ++i) { const int kk = 2 * i + (lane >> 5); wv[i] = __builtin_nontemporal_load(W + (size_t)(k0 + kk) * N + n0 + (lane & 31)); }
    const float g0 = gain ? gain[k0 + lane] : 1.0f;
#pragma unroll
    for (int i = 0; i < 32; ++i) { const int kk = 2 * i + (lane >> 5); scr[kk * 33 + (lane & 31)] = wv[i] * __shfl(g0, kk); }
    asm volatile("s_waitcnt lgkmcnt(0)" ::: "memory");
    const int c = lane & 7;
#pragma unroll
    for (int j = 0; j < 4; ++j) { const int n = (lane >> 3) + 8 * j; const LAS float* s = scr + (8 * c) * 33 + n;
        u32x4 o; o.x = pkh(s[0 * 33], s[1 * 33]); o.y = pkh(s[2 * 33], s[3 * 33]); o.z = pkh(s[4 * 33], s[5 * 33]); o.w = pkh(s[6 * 33], s[7 * 33]);
        *(u32x4*)(WT + (size_t)(n0 + n) * K + k0 + 8 * c) = o; }
    asm volatile("s_waitcnt lgkmcnt(0)" ::: "memory");
}
__device__ __forceinline__ void sincos_d(double a, float& s, float& c) {
    double rev = a * 0.15915494309189533577; rev -= __builtin_rint(rev); const double r = rev * 6.283185307179586476925, r2 = r * r;
    double ss = 1.0, cc = 1.0;
#pragma unroll
    for (int k = 12; k >= 1; --k) { ss = 1.0 - ss * r2 / (double)((2 * k) * (2 * k + 1)); cc = 1.0 - cc * r2 / (double)((2 * k - 1) * (2 * k)); }
    s = (float)(ss * r); c = (float)cc;
}
__device__ __forceinline__ void rope_tables(unsigned char* ws, int gtid, int gthreads) {
    const double bB = __builtin_sqrt(__builtin_sqrt(__builtin_sqrt(__builtin_sqrt(1.0 / 500000.0))));
    const double bC = __builtin_sqrt(__builtin_sqrt(__builtin_sqrt(__builtin_sqrt(__builtin_sqrt(1.0 / 10000.0)))));
    f32x2* tB = (f32x2*)(ws + WS_TABB); f32x2* tR = (f32x2*)(ws + WS_TABR); f32x2* tC = (f32x2*)(ws + WS_TABC);
    for (int e = gtid; e < 8192 * 16 + 128 * 32 + 64 * 32; e += gthreads) {
        int pos, i; double base; f32x2* dst;
        if (e < 8192 * 16) { pos = e >> 4; i = e & 15; base = bB; dst = tB + e; }
        else if (e < 8192 * 16 + 128 * 32) { const int f = e - 8192 * 16; pos = f >> 5; i = f & 31; base = bC; dst = tR + f; }
        else { const int f = e - 8192 * 16 - 128 * 32; pos = f >> 5; i = f & 31; base = bC; dst = tC + f; }
        double inv = 1.0; for (int k = 0; k < i; ++k) inv *= base;
        const float invf = (float)inv; const float ang = (float)pos * invf;
        float s, c; sincos_d((double)ang, s, c); *dst = (f32x2){c, s};
    }
}
__device__ __forceinline__ void cvt_phase(const float* x0, const float* x1, u16* H, float* ssq, int gw, int ngw, int lane) {
    for (int m = gw; m < MTOK; m += ngw) {
        const f32x4* xr = (const f32x4*)((m < NTOK_P ? x0 : x1) + (size_t)m * DM) + lane;
        f32x4 v[8]; float s = 0.f;
#pragma unroll
        for (int j = 0; j < 8; ++j) { v[j] = xr[64 * j]; s += (v[j].x * v[j].x + v[j].y * v[j].y) + (v[j].z * v[j].z + v[j].w * v[j].w); }
        s = wave_sum(s); if (lane == 0) ssq[m] = s;
        u32x2* o8 = (u32x2*)(H + (size_t)m * DM) + lane;
#pragma unroll
        for (int j = 0; j < 8; ++j) o8[64 * j] = (u32x2){pkh(v[j].x, v[j].y), pkh(v[j].z, v[j].w)};
    }
}
template <bool ODD>
__device__ __forceinline__ void prep_phase(u16* KV, const float* kn, const unsigned char* ws, int gw, int ngw, int lane) {
    constexpr int NKH = ODD ? 4 : 2;
    const f32x2* tB = (const f32x2*)(ws + WS_TABB); const f32x2* tR = (const f32x2*)(ws + WS_TABR); const f32x2* tC = (const f32x2*)(ws + WS_TABC);
    const int sub = lane >> 4, ls = lane & 15;
    const f32x4 g0 = *(const f32x4*)(kn + ls * 8), g1 = *(const f32x4*)(kn + ls * 8 + 4);
    constexpr int NB = 5;
    for (int it0 = gw; it0 < MTOK * NKH / 4; it0 += NB * ngw) {
        hx8 vv[NB];
#pragma unroll
        for (int b = 0; b < NB; ++b) { const int it = it0 + b * ngw; if (it < MTOK * NKH / 4) vv[b] = *(const hx8*)(KV + (size_t)(it * 4 + sub) * 128 + ls * 8); }
#pragma unroll
        for (int b = 0; b < NB; ++b) { const int it = it0 + b * ngw; if (it >= MTOK * NKH / 4) break;
        const int R = it * 4 + sub, kh = R / MTOK, row = R - kh * MTOK;
        const int t = row < NTOK_P ? (row & (SEQ_P - 1)) : ((row - NTOK_P) & (SEQ_S - 1));
        u16* p = KV + (size_t)R * 128 + ls * 8;
        const hx8 v = vv[b]; float y[8]; float ss = 0.f;
#pragma unroll
        for (int j = 0; j < 8; ++j) { y[j] = (float)v[j]; ss += y[j] * y[j]; }
        ss += __shfl_xor(ss, 1); ss += __shfl_xor(ss, 2); ss += __shfl_xor(ss, 4); ss += __shfl_xor(ss, 8);
        const float rstd = 1.0f / sqrtf(ss * (1.f / 128.f) + EPS);
#pragma unroll
        for (int j = 0; j < 4; ++j) { y[j] *= rstd * g0[j]; y[4 + j] *= rstd * g1[j]; }
        if (ODD) {
            const f32x4* tp = (const f32x4*)((ls < 8 ? tR + (t >> 6) * 32 : tC + (t & 63) * 32) + (ls & 3) * 8);
            const bool second = (ls & 4) != 0;
#pragma unroll
            for (int j2 = 0; j2 < 4; ++j2) { const f32x4 cs = tp[j2];
                const float pa = __shfl_xor(y[2 * j2], 4), pb = __shfl_xor(y[2 * j2 + 1], 4);
                y[2 * j2] = y[2 * j2] * cs.x + (second ? pa : -pa) * cs.y; y[2 * j2 + 1] = y[2 * j2 + 1] * cs.z + (second ? pb : -pb) * cs.w; }
        } else {
            const f32x4* tp = (const f32x4*)(tB + t * 16 + (ls & 1) * 8);
            const bool second = (ls & 2) != 0;
#pragma unroll
            for (int j2 = 0; j2 < 4; ++j2) { const f32x4 cs = tp[j2];
                const float pa = __shfl_xor(y[2 * j2], 2), pb = __shfl_xor(y[2 * j2 + 1], 2);
                const float ya = y[2 * j2] * cs.x + (second ? pa : -pa) * cs.y, yb = y[2 * j2 + 1] * cs.z + (second ? pb : -pb) * cs.w;
                if (ls < 4) { y[2 * j2] = ya; y[2 * j2 + 1] = yb; } }
        }
        *(u32x4*)p = (u32x4){pkh(y[0], y[1]), pkh(y[2], y[3]), pkh(y[4], y[5]), pkh(y[6], y[7])};
        }
    }
}
__device__ __forceinline__ void mixer_a_phase(const u16* Z, u16* Y, const float* vnorm, const float* wsp, const float* bsp, int c, int G, LAS char* lds) {
    constexpr int PIT = 136, MP = 132, NU = (MTOK / 128) * 8;
    int tid = threadIdx.x; asm volatile("" : "+v"(tid));
    const int wid = tid >> 6, lane = tid & 63, r32 = lane & 31, hi = lane >> 5;
    LAS u16* vnT = (LAS u16*)lds; LAS float* mx = (LAS float*)(lds + 36864);
    const int q = tid >> 2, part = tid & 3, pb = wid & 3, dh = wid >> 2;
    hx8 nv[4], nu[4], ng[4];
#define MA_LOAD(unit) do { const u16* src_ = Z + (size_t)(((unit) >> 3) * 128 + q) * AB_IN + ((unit) & 7) * 128 + part * 32; \
    _Pragma("unroll") for (int j = 0; j < 4; ++j) { nv[j] = *(const hx8*)(src_ + 1024 + 8 * j); nu[j] = *(const hx8*)(src_ + 8 * j); ng[j] = *(const hx8*)(src_ + 2048 + 8 * j); } } while (0)
    int gcur = -1; hx8 af[8]; float bsv[16]; float gnv[32];
    if (c < NU) MA_LOAD(c);
    for (int ua = c; ua < NU; ua += G) {
        const int chunk = ua >> 3, g = ua & 7;
        hx8 v[4], u[4], gt[4];
#pragma unroll
        for (int j = 0; j < 4; ++j) { v[j] = nv[j]; u[j] = nu[j]; gt[j] = ng[j]; }
        if (g != gcur) {
            const float* wrow = wsp + (size_t)g * 128 * 128 + (size_t)(pb * 32 + r32) * 128 + hi * 8;
#pragma unroll
            for (int ks = 0; ks < 8; ++ks) { const f32x4 a0 = *(const f32x4*)(wrow + ks * 16), a1 = *(const f32x4*)(wrow + ks * 16 + 4);
                af[ks] = (hx8){(_Float16)a0.x, (_Float16)a0.y, (_Float16)a0.z, (_Float16)a0.w, (_Float16)a1.x, (_Float16)a1.y, (_Float16)a1.z, (_Float16)a1.w}; }
#pragma unroll
            for (int r = 0; r < 16; ++r) bsv[r] = bsp[g * 128 + pb * 32 + att::crow(r, hi)];
#pragma unroll
            for (int j = 0; j < 8; ++j) { const f32x4 t4 = *(const f32x4*)(vnorm + g * 128 + part * 32 + 4 * j); gnv[4 * j] = t4.x; gnv[4 * j + 1] = t4.y; gnv[4 * j + 2] = t4.z; gnv[4 * j + 3] = t4.w; }
            gcur = g;
        }
        { float ss = 0.f;
#pragma unroll
          for (int j = 0; j < 4; ++j)
#pragma unroll
              for (int e = 0; e < 8; ++e) { const float f = (float)v[j][e]; ss += f * f; }
          ss += __shfl_xor(ss, 1); ss += __shfl_xor(ss, 2);
          const float rstd = 1.0f / sqrtf(ss * (1.f / 128.f) + EPS);
#pragma unroll
          for (int j = 0; j < 4; ++j)
#pragma unroll
              for (int e = 0; e < 8; ++e) vnT[(part * 32 + j * 8 + e) * PIT + q] = f2h((float)v[j][e] * rstd * gnv[j * 8 + e]); }
        __syncthreads();
        if (ua + G < NU) MA_LOAD(ua + G);
        f32x16 acc0 = {}, acc1 = {};
#pragma unroll
        for (int ks = 0; ks < 8; ++ks) {
            const hx8 b0 = *(const LAS hx8*)(vnT + (dh * 64 + r32) * PIT + ks * 16 + hi * 8);
            const hx8 b1 = *(const LAS hx8*)(vnT + (dh * 64 + 32 + r32) * PIT + ks * 16 + hi * 8);
            acc0 = __builtin_amdgcn_mfma_f32_32x32x16_f16(af[ks], b0, acc0, 0, 0, 0);
            acc1 = __builtin_amdgcn_mfma_f32_32x32x16_f16(af[ks], b1, acc1, 0, 0, 0);
        }
#pragma unroll
        for (int r = 0; r < 16; ++r) { LAS float* mp = mx + (pb * 32 + att::crow(r, hi)) * MP + dh * 64 + r32; mp[0] = acc0[r] + bsv[r]; mp[32] = acc1[r] + bsv[r]; }
        __syncthreads();
        { u16* yr = Y + (size_t)(chunk * 128 + q) * DM + g * 128 + part * 32; const LAS float* mr = mx + q * MP + part * 32;
#pragma unroll
          for (int j = 0; j < 4; ++j) { const f32x4 m0 = *(const LAS f32x4*)(mr + 8 * j), m1 = *(const LAS f32x4*)(mr + 8 * j + 4);
              float o[8];
#pragma unroll
              for (int e = 0; e < 4; ++e) { o[e] = (float)u[j][e] * m0[e] * (float)gt[j][e]; o[4 + e] = (float)u[j][4 + e] * m1[e] * (float)gt[j][4 + e]; }
              *(u32x4*)(yr + 8 * j) = (u32x4){pkh(o[0], o[1]), pkh(o[2], o[3]), pkh(o[4], o[5]), pkh(o[6], o[7])}; } }
    }
    __syncthreads();
#undef MA_LOAD
}

#define XB_TMO      128
#define XB_XCNT(j)  (256  + 64 * (j))
#define XB_XSUB(j)  (1280 + 64 * (j))
#define XB_XGEN(j)  (2304 + 64 * (j))
#define XB_TOP      3328
#define XB_TOPGEN   3392
#define XCD_BAR_WORDS 3456
#define XB_SPIN_CAP (1u << 18)

__device__ __forceinline__ unsigned xb_ld(unsigned* p)              { return __hip_atomic_load(p, __ATOMIC_RELAXED, __HIP_MEMORY_SCOPE_AGENT); }
__device__ __forceinline__ unsigned xb_add(unsigned* p, unsigned v) { return __hip_atomic_fetch_add(p, v, __ATOMIC_RELAXED, __HIP_MEMORY_SCOPE_AGENT); }
__device__ __forceinline__ unsigned xb_xcc_id() { return (unsigned)__builtin_amdgcn_s_getreg((3 << 11) | 20) & 0xFu; }
#define XB_SPIN(cond, bar) do { unsigned _sp = 0; while (cond) { __builtin_amdgcn_s_sleep(1); \
    if ((++_sp & 255u) == 0u) { if (xb_ld(&(bar)[XB_TMO])) break; if (_sp > XB_SPIN_CAP) { atomicAdd(&(bar)[XB_TMO], 1u); break; } } } } while (0)

struct XcdBarrier {
    unsigned* bar; unsigned x;
    volatile LAS unsigned* st;
};

__device__ __forceinline__ XcdBarrier xcd_barrier_post(unsigned* bar, volatile LAS unsigned* st) {
    XcdBarrier b; b.bar = bar; b.x = xb_xcc_id(); b.st = st;
    if (threadIdx.x == 0) (void)xb_add(&bar[XB_XCNT(b.x)], 1u);
    return b;
}
__device__ __forceinline__ void xcd_barrier_complete(unsigned* bar, unsigned x, unsigned& nloc, unsigned& nx) {
    const unsigned G = gridDim.x * gridDim.y * gridDim.z;
    unsigned sum, cnt, mine, sp = 0u;
    for (;;) {
        sum = 0u; cnt = 0u; mine = 0u;
#pragma unroll
        for (unsigned j = 0; j < 16; ++j) { const unsigned c = xb_ld(&bar[XB_XCNT(j)]); sum += c; cnt += (c > 0u) ? 1u : 0u; mine = (j == x) ? c : mine; }
        if (sum == G) break;
        __builtin_amdgcn_s_sleep(1);
        if ((++sp & 255u) == 0u) { if (xb_ld(&bar[XB_TMO])) break; if (sp > XB_SPIN_CAP) { atomicAdd(&bar[XB_TMO], 1u); break; } }
    }
    nloc = mine > 0u ? mine : 1u; nx = cnt > 0u ? cnt : 1u;
}

__device__ __forceinline__ void xcd_barrier(const XcdBarrier& b) {
    asm volatile("s_waitcnt vmcnt(0)" ::: "memory");
    __syncthreads();
    if (threadIdx.x == 0) {
        unsigned* bar = b.bar;
        __builtin_amdgcn_s_waitcnt(0);
        unsigned nloc = b.st[0], nx = b.st[1];
        if (nloc == 0u) { xcd_barrier_complete(bar, b.x, nloc, nx); b.st[0] = nloc; b.st[1] = nx; }
        const unsigned old = xb_add(&bar[XB_XSUB(b.x)], 1u);
        const unsigned gen = old / nloc;
        if (old + 1u == (gen + 1u) * nloc) {
            __builtin_amdgcn_fence(__ATOMIC_RELEASE, "agent");
            asm volatile("s_waitcnt vmcnt(0)" ::: "memory");
            const unsigned og = xb_add(&bar[XB_TOP], 1u);
            const unsigned tg = og / nx;
            if (og + 1u == (tg + 1u) * nx) xb_add(&bar[XB_TOPGEN], 1u);
            else XB_SPIN(xb_ld(&bar[XB_TOPGEN]) == tg, bar);
            __builtin_amdgcn_fence(__ATOMIC_ACQUIRE, "agent");
            xb_add(&bar[XB_XGEN(b.x)], 1u);
            asm volatile("s_waitcnt vmcnt(0)" ::: "memory");
        } else {
            XB_SPIN(xb_ld(&bar[XB_XGEN(b.x)]) == gen, bar);
            __builtin_amdgcn_fence(__ATOMIC_ACQUIRE, "agent");
            asm volatile("s_waitcnt vmcnt(0)" ::: "memory");
        }
    }
    __syncthreads();
}

__global__ void __launch_bounds__(512) mega_fwd(Args args) {
    extern __shared__ __attribute__((aligned(16))) unsigned char lds_raw[];
    LAS unsigned char* lds = (LAS unsigned char*)lds_raw;
    const int ph_lo = args.ph_lo, ph_hi = args.ph_hi;
    volatile LAS unsigned* bst = (volatile LAS unsigned*)(lds + 147456 + 64);
    if (threadIdx.x == 0) { bst[0] = 0u; bst[1] = 0u; }
    __syncthreads();
    if (ph_hi - ph_lo > 1) (void)xcd_barrier_post((unsigned*)(args.ws + WS_BAR), bst);

    constexpr int I_AB = 32 * (AB_IN / 32), I_C = 32 * (C_IN / 32), I_O = 32 * (DM / 32);
#define TR_LAYER(Lx, gwi, nwi) do { const int l2_ = (Lx) >> 1; LAS float* scr_ = (LAS float*)(lds + wave * 16384); \
        if ((Lx) & 1) { for (int it_ = (gwi); it_ < I_C + I_O; it_ += (nwi)) { \
            if (it_ < I_C) p0_transpose_item(ap->in[12] + (size_t)l2_ * DM * C_IN, ap->in[11] + l2_ * DM, DM, C_IN, (u16*)(ws + WS_WIN_C) + (size_t)l2_ * C_IN * DM, scr_, it_, lane); \
            else p0_transpose_item(ap->in[13] + (size_t)l2_ * DM * DM, nullptr, DM, DM, (u16*)(ws + WS_WOUT_C) + (size_t)l2_ * DM * DM, scr_, it_ - I_C, lane); } } \
        else { for (int it_ = (gwi); it_ < I_AB + I_O; it_ += (nwi)) { \
            if (it_ < I_AB) p0_transpose_item(ap->in[3] + (size_t)l2_ * DM * AB_IN, ap->in[2] + l2_ * DM, DM, AB_IN, (u16*)(ws + WS_WIN_AB) + (size_t)l2_ * AB_IN * DM, scr_, it_, lane); \
            else p0_transpose_item(ap->in[4] + (size_t)l2_ * DM * DM, nullptr, DM, DM, (u16*)(ws + WS_WOUT_AB) + (size_t)l2_ * DM * DM, scr_, it_ - I_AB, lane); } } } while (0)
#ifndef PROBE_SUB
#define PROBE_SUB -1
#endif
#ifndef PROBE_PAR
#define PROBE_PAR 2
#endif
    for (int ph = ph_lo; ph < ph_hi; ++ph) {
      const int nrep = (PROBE_SUB >= 0 && ph > 0 && (ph - 1) % 4 == PROBE_SUB && (PROBE_PAR == 2 || (((ph - 1) / 4) & 1) == PROBE_PAR)) ? 2 : ((PROBE_SUB == -2 && ph == 0) ? 2 : 1);
      for (int rep = 0; rep < nrep; ++rep) {
        typedef const __attribute__((address_space(4))) Args* kargs_t;
        kargs_t ap; { auto k = __builtin_amdgcn_kernarg_segment_ptr(); asm volatile("" : "+s"(k)); ap = (kargs_t)k; }
        int tid = threadIdx.x, G = gridDim.x, c = blockIdx.x; asm volatile("" : "+v"(tid), "+s"(G), "+s"(c));
        const int lane = tid & 63, wave = __builtin_amdgcn_readfirstlane(tid >> 6), gw = c * 8 + wave, ngw = G * 8;
        unsigned char* ws = ap->ws; float* out = ap->out;
        u16* H = (u16*)(ws + WS_H); u16* Y = (u16*)(ws + WS_Y); u16* Z = (u16*)(ws + WS_Z); u16* KV = (u16*)(ws + WS_KV); float* SSQ = (float*)(ws + WS_SSQ);
        const float* xs_off = ap->in[1] - (size_t)NTOK_P * DM;
        if (ph == 0) {
            TR_LAYER(0, gw, ngw);
            rope_tables(ws, c * 512 + tid, G * 512);
            for (int e = c * 512 + tid; e < 3 * MTOK; e += G * 512) SSQ[MTOK + e] = 0.f;
            cvt_phase(ap->in[0], xs_off, H, SSQ, gw, ngw, lane);
        } else {
            const int L = (ph - 1) / 4, sub = (ph - 1) % 4, li = L >> 1; const bool odd = (L & 1) != 0;
            if (sub == 0) {
#ifndef NO_GEMM_IN
                LAS float* rst = (LAS float*)(lds + 131072);
#define RST_FILL() do { const float* ssq_ = SSQ + L * MTOK; for (int i_ = 0; i_ < 16; ++i_) { pg8::Unit u_; if (!S.next(i_, u_)) break; \
                    if (tid < 256) rst[i_ * 256 + tid] = 1.0f / sqrtf(ssq_[u_.pm * 256 + tid] * (1.f / DM) + EPS); } __syncthreads(); } while (0)
                if (!odd) { pg8::Gemm g{H, (const u16*)(ws + WS_WIN_AB) + (size_t)li * AB_IN * DM, MTOK, AB_IN, DM}; pg8::StaticOrder S; S.init(MTOK, AB_IN, G, c);
                    RST_FILL(); pg8::EpiAct E{Z, AB_IN, 2048, 3072, 4608, KV, 4096, 4608, rst}; pg8::gemm_phase<pg8::EpiAct, pg8::StaticOrder, true, true>(lds, g, S, E); }
                else { pg8::Gemm g{H, (const u16*)(ws + WS_WIN_C) + (size_t)li * C_IN * DM, MTOK, C_IN, DM}; pg8::StaticOrder S; S.init(MTOK, C_IN, G, c);
                    RST_FILL(); pg8::EpiAct E{Z, C_IN, 0, 0, 3072, KV, 2048, 3072, rst}; pg8::gemm_phase<pg8::EpiAct, pg8::StaticOrder, true, true>(lds, g, S, E); }
                if (L < 3) { const int nwg_ = (MTOK / 256) * ((odd ? C_IN : AB_IN) / 256), nr_ = (nwg_ + G - 1) / G; int c0_ = nwg_ - (nr_ - 1) * G; if (c0_ >= G) c0_ = 0;
                    if (c >= c0_) TR_LAYER(L + 1, (c - c0_) * 8 + wave, (G - c0_) * 8); }
#endif
            } else if (sub == 1) {
                if (!odd) prep_phase<false>(KV, ap->in[9] + li * 128, ws, gw, ngw, lane);
                else prep_phase<true>(KV, ap->in[15] + li * 128, ws, gw, ngw, lane);
            } else if (sub == 2) {
                if (!odd) {
#ifndef NO_MIXB
                    {
                    const int vcb = (G % 8 == 0) ? (c & 7) * (G / 8) + (c >> 3) : c;
                    for (int ub = vcb; ub < (MTOK / 128) * 4; ub += G) {
                        const int blk = ub >> 2, h0 = (ub & 3) * 2, kvh = h0 >> 2; int seq0, S_, i0;
                        if (blk < NTOK_P / 128) { seq0 = (blk / (SEQ_P / 128)) * SEQ_P; S_ = SEQ_P; i0 = (blk % (SEQ_P / 128)) * 128; }
                        else { const int r2 = blk - NTOK_P / 128; seq0 = NTOK_P + (r2 / (SEQ_S / 128)) * SEQ_S; S_ = SEQ_S; i0 = (r2 % (SEQ_S / 128)) * 128; }
                        const int k_lo = i0 >= 128 ? i0 - 128 : 0, k_hi = (i0 + 256 <= S_) ? i0 + 256 : S_, NT = (k_hi - k_lo) >> 6;
                        const u16* zq = Z + (size_t)(seq0 + i0) * AB_IN; const u16* kvp = KV + (size_t)(seq0 + k_lo) * 128;
                        const int un = ub + G; const bool hn = un < (MTOK / 128) * 4;
                        const u16* qnext = hn ? Z + (size_t)((un >> 2) * 128) * AB_IN + 3072 + ((un & 3) * 2) * 128 : nullptr;
                        att::attn_unit<true, AB_IN, 2>(zq + 3072 + h0 * 128, kvp + (size_t)kvh * MTOK * 128, kvp + (size_t)(2 + kvh) * MTOK * 128, zq + 4608 + h0 * 128,
                                                    Y + (size_t)(seq0 + i0) * DM + 1024 + h0 * 128, NT, ap->in[10] + li * 8 + h0, i0 - k_lo, (LAS char*)lds,
                                                    ap->in[8] + li * 128, (const f32x2*)(ws + WS_TABB), (const f32x2*)(ws + WS_TABB), i0);
                        __syncthreads();
                    } }
#endif
#ifndef NO_MIXA
                    mixer_a_phase(Z, Y, ap->in[5] + li * 1024, ap->in[6] + (size_t)li * 8 * 128 * 128, ap->in[7] + li * 1024, c, G, (LAS char*)lds);
#endif
                } else {
#ifndef NO_MIXC
                    const int nun = (G == 256) ? 10 : (2560 + G - 1) / G;
#define MC_UNIT(i_, ok_, b_, h_, qb_, samp_) do { ok_ = true; \
                        if (G == 256) { const int x_ = c & 7, l_ = c >> 3; \
                            if ((i_) < 8) { const int pair_ = 2 * x_ + ((i_) >> 2); b_ = pair_ >> 2; h_ = (pair_ & 3) * 4 + ((i_) & 3); qb_ = l_; samp_ = false; } \
                            else { const int pair_ = 2 * x_ + ((i_) - 8); b_ = pair_ >> 2; h_ = (pair_ & 3) * 4 + (l_ >> 3); qb_ = l_ & 7; samp_ = true; } \
                            if ((i_) >= 10) ok_ = false; \
                        } else { const int u_ = c + (i_) * G; if (u_ >= 2560) ok_ = false; \
                            if (u_ < 2048) { b_ = u_ >> 9; h_ = (u_ >> 5) & 15; qb_ = u_ & 31; samp_ = false; } else { const int v_ = u_ - 2048; b_ = v_ >> 7; h_ = (v_ >> 3) & 15; qb_ = v_ & 7; samp_ = true; } } } while (0)
                    {
                    for (int i = 0; i < nun; ++i) {
                        int b, h, qb; bool samp, ok; MC_UNIT(i, ok, b, h, qb, samp); if (!ok) break;
                        const int seq0 = samp ? NTOK_P + b * SEQ_S : b * SEQ_P, S_ = samp ? SEQ_S : SEQ_P, i0 = qb * 256;
                        const u16* zq = Z + (size_t)(seq0 + i0) * C_IN; const u16* kvp = KV + (size_t)seq0 * 128;
                        int bn, hn_, qbn; bool sampn, okn; MC_UNIT(i + 1, okn, bn, hn_, qbn, sampn); okn = okn && (i + 1 < nun);
                        const u16* qnext = okn ? Z + (size_t)((sampn ? NTOK_P + bn * SEQ_S : bn * SEQ_P) + qbn * 256) * C_IN + hn_ * 128 : nullptr;
                        att::attn_unit<false, C_IN, 2>(zq + h * 128, kvp + (size_t)(h >> 2) * MTOK * 128, kvp + (size_t)(4 + (h >> 2)) * MTOK * 128, zq + 3072 + h * 128,
                                                    Y + (size_t)(seq0 + i0) * DM + h * 128, S_ >> 6, nullptr, 0, (LAS char*)lds,
                                                    ap->in[14] + li * 128, (const f32x2*)(ws + WS_TABR), (const f32x2*)(ws + WS_TABC), i0);
                        __syncthreads();
                    } }
#undef MC_UNIT
#endif
                }
            } else {
#ifndef NO_GEMM_OUT
                const u16* wt = odd ? (const u16*)(ws + WS_WOUT_C) + (size_t)li * DM * DM : (const u16*)(ws + WS_WOUT_AB) + (size_t)li * DM * DM;
                pg8::Gemm g{Y, wt, MTOK, DM, DM}; pg8::StaticOrder S; S.init(MTOK, DM, G, c);
                pg8::EpiRes E{L == 0 ? ap->in[0] : nullptr, L == 0 ? xs_off : nullptr, H, L == 3 ? out : nullptr, DM, NTOK_P, L < 3 ? H : nullptr, SSQ + (L < 3 ? L + 1 : 0) * MTOK};
                pg8::gemm_phase<pg8::EpiRes, pg8::StaticOrder, true, true>(lds, g, S, E);
#endif
            }
        }
        if (ph + 1 < ph_hi || rep + 1 < nrep) {
            if (ph == ph_lo && rep == 0) cg::this_grid().sync();
            else { XcdBarrier xb; xb.bar = (unsigned*)(ap->ws + WS_BAR); xb.x = xb_xcc_id(); xb.st = bst; xcd_barrier(xb); }
        }
      }
    }
}

extern "C" void kernel_launch(void* const* d_in, const int* in_sizes, int n_in, void* d_out, int out_size, void* d_ws, size_t ws_size, hipStream_t stream) {
    static int grid = 0;
    if (grid == 0) {
        if (n_in != 16 || out_size != MTOK * DM || ws_size < WS_END) { fprintf(stderr, "kernel_launch: unexpected shapes: n_in %d out %d ws %zu (need %zu)\n", n_in, out_size, ws_size, (size_t)WS_END); grid = -1; return; }
        int dev = 0, cus = 0, per_cu = 0;
        if (hipGetDevice(&dev) != hipSuccess || hipDeviceGetAttribute(&cus, hipDeviceAttributeMultiprocessorCount, dev) != hipSuccess) { fprintf(stderr, "kernel_launch: device query failed\n"); grid = -1; return; }
        if (hipFuncSetAttribute((const void*)mega_fwd, hipFuncAttributeMaxDynamicSharedMemorySize, LDS_BYTES) != hipSuccess) { fprintf(stderr, "kernel_launch: hipFuncSetAttribute failed\n"); grid = -1; return; }
        if (hipOccupancyMaxActiveBlocksPerMultiprocessor(&per_cu, (const void*)mega_fwd, 512, LDS_BYTES) != hipSuccess || per_cu < 1) { fprintf(stderr, "kernel_launch: occupancy query gave %d\n", per_cu); (void)hipGetLastError(); per_cu = 1; }
        if (cus * 16 < (MTOK / 256) * (AB_IN / 256)) { fprintf(stderr, "kernel_launch: %d CUs: the in-projection phase would give a workgroup more than 16 units (its LDS table of row scales holds 16)\n", cus); grid = -1; return; }
        grid = cus * 1;
    }
    if (grid < 0) return;
    if (hipMemsetAsync((char*)d_ws + WS_BAR, 0, BAR_BYTES, stream) != hipSuccess) { fprintf(stderr, "kernel_launch: memset of the barrier words failed\n"); return; }
    Args a{};
    for (int i = 0; i < 16; ++i) a.in[i] = (const float*)d_in[i];
    a.out = (float*)d_out; a.ws = (unsigned char*)d_ws;
#if MK_MULTI
    for (int ph = 0; ph < NPHASE; ++ph) { a.ph_lo = ph; a.ph_hi = ph + 1;
        hipLaunchKernelGGL(mega_fwd, dim3(grid), dim3(512), LDS_BYTES, stream, a);
        const hipError_t le = hipPeekAtLastError(); if (le != hipSuccess) { fprintf(stderr, "kernel_launch: launch %d failed: %s\n", ph, hipGetErrorName(le)); break; } }
#else
    a.ph_lo = 0; a.ph_hi = NPHASE;
    void* kargs[] = {&a};
    const hipError_t le = hipLaunchCooperativeKernel((const void*)mega_fwd, dim3(grid), dim3(512), kargs, LDS_BYTES, stream);
    if (le != hipSuccess) fprintf(stderr, "kernel_launch: cooperative launch failed: %s (grid %d)\n", hipGetErrorString(le), grid);
#endif
}
```

```cpp
#include <hip/hip_runtime.h>
#include <hip/hip_cooperative_groups.h>
#include <cstdio>
#include <cstdint>
namespace cg = cooperative_groups;

#define LAS __attribute__((address_space(3)))
typedef unsigned short u16;
typedef _Float16 hx8 __attribute__((ext_vector_type(8)));
typedef _Float16 hx4 __attribute__((ext_vector_type(4)));
typedef _Float16 hx2 __attribute__((ext_vector_type(2)));
typedef short s16x4 __attribute__((ext_vector_type(4)));
typedef short s16x8 __attribute__((ext_vector_type(8)));
typedef float f32x2 __attribute__((ext_vector_type(2)));
typedef float f32x4 __attribute__((ext_vector_type(4)));
typedef float f32x16 __attribute__((ext_vector_type(16)));
typedef unsigned u32x2 __attribute__((ext_vector_type(2)));
typedef unsigned u32x4 __attribute__((ext_vector_type(4)));

constexpr int DM = 2048, SEQ_P = 8192, SEQ_S = 2048, NTOK_P = 4 * SEQ_P, NTOK_S = 4 * SEQ_S, MTOK = NTOK_P + NTOK_S;
constexpr int AB_IN = 5632, C_IN = 5120;
constexpr float EPS = 1e-6f;
#ifndef MK_MULTI
#define MK_MULTI 0
#endif

__device__ __forceinline__ unsigned pkh(float lo, float hi) { hx2 v = {(_Float16)lo, (_Float16)hi}; return __builtin_bit_cast(unsigned, v); }
__device__ __forceinline__ float h2f(u16 b) { return (float)__builtin_bit_cast(_Float16, b); }
__device__ __forceinline__ u16 f2h(float f) { return __builtin_bit_cast(u16, (_Float16)f); }
__device__ __forceinline__ float wave_sum(float v) {
#pragma unroll
    for (int o = 1; o < 64; o <<= 1) v += __shfl_xor(v, o);
    return v;
}
__device__ __forceinline__ float sigmoidf_fast(float t) { return __builtin_amdgcn_rcpf(1.0f + __expf(-t)); }
__device__ __forceinline__ float gelu_tanh(float v) { const float u = 0.7978845608028654f * (v + 0.044715f * v * v * v); return v * sigmoidf_fast(2.0f * u); }
__device__ __forceinline__ float silu_f(float v) { return v * sigmoidf_fast(v); }
__device__ __forceinline__ f32x2 act_tail2(f32x2 v, f32x2 a) { f32x2 ex; ex.x = __builtin_amdgcn_exp2f(a.x); ex.y = __builtin_amdgcn_exp2f(a.y); const f32x2 d = ex + 1.0f; f32x2 r; r.x = __builtin_amdgcn_rcpf(d.x); r.y = __builtin_amdgcn_rcpf(d.y); return v * r; }
__device__ __forceinline__ f32x2 gelu2(f32x2 v) { const f32x2 p = (v * v) * (-0.10294323970f) + (-2.30220819813f); return act_tail2(v, v * p); }
__device__ __forceinline__ f32x2 silu2(f32x2 v) { return act_tail2(v, v * (-1.4426950408889634f)); }
__device__ __forceinline__ f32x4 gelu4(f32x4 v) { const f32x2 a = gelu2((f32x2){v[0], v[1]}), b = gelu2((f32x2){v[2], v[3]}); return (f32x4){a.x, a.y, b.x, b.y}; }
__device__ __forceinline__ f32x4 silu4(f32x4 v) { const f32x2 a = silu2((f32x2){v[0], v[1]}), b = silu2((f32x2){v[2], v[3]}); return (f32x4){a.x, a.y, b.x, b.y}; }

namespace pg8 {
#define PG8_LAS __attribute__((address_space(3)))
typedef unsigned short bf16_t;
typedef _Float16 bf16x8 __attribute__((ext_vector_type(8)));
typedef float f32x4 __attribute__((ext_vector_type(4)));
typedef unsigned u32x4 __attribute__((ext_vector_type(4)));
constexpr int BM = 256, BK = 64, HALF = 128, HTB = HALF * BK * 2  , STAGE_BYTES = 8 * HTB, NXCD = 8, WGM = 4;

__host__ __device__ __forceinline__ int lds_byte(int r, int c) { const int st = (r >> 4) * 2 + (c >> 5), rr = r & 15, cc = c & 31, ob = rr * 64 + cc * 2; return st * 1024 + (ob ^ (((ob >> 9) & 1) << 5)); }
__host__ __device__ __forceinline__ void stage_rc(int b, int& R, int& C) { const int st = b / 1024, sb = b % 1024, swz = sb ^ (((sb >> 9) & 1) << 5); R = (st >> 1) * 16 + swz / 64; C = (st & 1) * 32 + (swz % 64) / 2; }
__host__ __device__ __forceinline__ int perm32(int rho) { const int n = rho >> 4, i = rho & 15; return 8 * (i >> 2) + 4 * n + (i & 3); }

struct Unit { int pm, pn, idx; };
struct Gemm { const bf16_t* A; const bf16_t* Bt; int M, N, K; };

struct StaticOrder {
    int nM, nN, nwg, G, c;
    __host__ __device__ void init(int M, int N, int G_, int c_) { nM = M / BM; nN = N / BM; nwg = nM * nN; G = G_; c = c_; }
    __host__ __device__ bool next(int i, Unit& u) const {
        const long L = (long)i * G + c; if (L >= nwg) return false;
        int wgid = (int)L; { const int q = nwg / NXCD, r = nwg % NXCD, xcd = wgid % NXCD, off = wgid / NXCD; wgid = (xcd < r ? xcd * (q + 1) : r * (q + 1) + (xcd - r) * q) + off; }
        const int nig = WGM * nN, gid = wgid / nig, fm = gid * WGM, gsz = (nM - fm) < WGM ? (nM - fm) : WGM;
        u.pm = fm + ((wgid % nig) % gsz); u.pn = (wgid % nig) / gsz; u.idx = i; return true;
    }
    __device__ __forceinline__ void a_ready(const Unit&) const {}
    __device__ __forceinline__ void done(const Unit&) const {}
};

struct EpiAct {
    static constexpr bool PERM = true, AFTER_DRAIN = false;
    u16* O; int ldc; int g_end, s_end, n_end; u16* KV; int kv_lo, kv_hi; const LAS float* rst;
    template <int ACT> __device__ __forceinline__ void run(const f32x4 (&acc)[2][2][4][2], const Unit& u, int wr, int wc, int fr, int fq) const {
        const int row0 = u.pm * BM + wr * 64 + fr, col0 = u.pn * BM + wc * 32 + 8 * fq;
#pragma unroll
        for (int ai = 0; ai < 2; ++ai)
#pragma unroll
            for (int m = 0; m < 4; ++m) { u16* rowp = O + (size_t)(row0 + ai * HALF + m * 16) * ldc + col0;
                const float rs = rst[u.idx * 256 + wr * 64 + fr + ai * HALF + m * 16];
#pragma unroll
                for (int bj = 0; bj < 2; ++bj) { f32x4 v0 = acc[ai][bj][m][0] * rs, v1 = acc[ai][bj][m][1] * rs;
                    if (ACT == 1) { v0 = gelu4(v0); v1 = gelu4(v1); }
                    if (ACT == 2) { v0 = silu4(v0); v1 = silu4(v1); }
                    u32x4 w; w.x = pkh(v0[0], v0[1]); w.y = pkh(v0[2], v0[3]); w.z = pkh(v1[0], v1[1]); w.w = pkh(v1[2], v1[3]);
                    __builtin_nontemporal_store(w, (u32x4*)(rowp + bj * HALF)); } }
    }
    __device__ __forceinline__ void run_kv(const f32x4 (&acc)[2][2][4][2], const Unit& u, int wr, int wc, int fr, int fq) const {
        const int row0 = u.pm * BM + wr * 64 + fr, slot0 = (u.pn * BM - kv_lo) >> 7;
#pragma unroll
        for (int ai = 0; ai < 2; ++ai)
#pragma unroll
            for (int m = 0; m < 4; ++m) { const float rs = rst[u.idx * 256 + wr * 64 + fr + ai * HALF + m * 16];
#pragma unroll
                for (int bj = 0; bj < 2; ++bj) { const f32x4 v0 = acc[ai][bj][m][0] * rs, v1 = acc[ai][bj][m][1] * rs;
                    u32x4 w; w.x = pkh(v0[0], v0[1]); w.y = pkh(v0[2], v0[3]); w.z = pkh(v1[0], v1[1]); w.w = pkh(v1[2], v1[3]);
                    *(u32x4*)(KV + ((size_t)(slot0 + bj) * MTOK + (row0 + ai * HALF + m * 16)) * 128 + wc * 32 + 8 * fq) = w; } }
    }
    __device__ __forceinline__ void operator()(const f32x4 (&acc)[2][2][4][2], const Unit& u, int wr, int wc, int fr, int fq) const {
        const int colt = u.pn * BM; if (colt >= kv_lo && colt < kv_hi) { run_kv(acc, u, wr, wc, fr, fq); return; }
        const int act = colt < g_end ? 1 : (colt < s_end ? 2 : (colt < n_end ? 0 : 2));
        if (act == 1) run<1>(acc, u, wr, wc, fr, fq); else if (act == 2) run<2>(acc, u, wr, wc, fr, fq); else run<0>(acc, u, wr, wc, fr, fq);
    }
};
struct EpiRes {
    static constexpr bool PERM = true, AFTER_DRAIN = false;
    const float* base0; const float* base1; const u16* Hb; float* out; int ldc; int split_row; u16* Hn; float* ssqn;
    __device__ __forceinline__ void operator()(const f32x4 (&acc)[2][2][4][2], const Unit& u, int wr, int wc, int fr, int fq) const {
        const int row0 = u.pm * BM + wr * 64 + fr, col0 = u.pn * BM + wc * 32 + 8 * fq;
        const float* base = (u.pm * BM < split_row) ? base0 : base1;
#pragma unroll
        for (int ai = 0; ai < 2; ++ai)
#pragma unroll
            for (int m = 0; m < 4; ++m) { const size_t off = (size_t)(row0 + ai * HALF + m * 16) * ldc + col0; float s = 0.f;
#pragma unroll
                for (int bj = 0; bj < 2; ++bj) { f32x4 b0, b1;
                    if (base0) { b0 = __builtin_nontemporal_load((const f32x4*)(base + off + bj * HALF)); b1 = __builtin_nontemporal_load((const f32x4*)(base + off + bj * HALF + 4)); }
                    else { const hx8 hb = *(const hx8*)(Hb + off + bj * HALF); b0 = (f32x4){(float)hb[0], (float)hb[1], (float)hb[2], (float)hb[3]}; b1 = (f32x4){(float)hb[4], (float)hb[5], (float)hb[6], (float)hb[7]}; }
                    const f32x4 x0 = b0 + acc[ai][bj][m][0], x1 = b1 + acc[ai][bj][m][1];
                    if (out) { __builtin_nontemporal_store(x0, (f32x4*)(out + off + bj * HALF)); __builtin_nontemporal_store(x1, (f32x4*)(out + off + bj * HALF + 4)); }
                    if (Hn) { *(u32x4*)(Hn + off + bj * HALF) = (u32x4){pkh(x0[0], x0[1]), pkh(x0[2], x0[3]), pkh(x1[0], x1[1]), pkh(x1[2], x1[3])};
                        s += ((x0[0] * x0[0] + x0[1] * x0[1]) + (x0[2] * x0[2] + x0[3] * x0[3])) + ((x1[0] * x1[0] + x1[1] * x1[1]) + (x1[2] * x1[2] + x1[3] * x1[3])); } }
                if (Hn) { s += __shfl_xor(s, 16); s += __shfl_xor(s, 32); if (fq == 0) atomicAdd(ssqn + row0 + ai * HALF + m * 16, s); } }
    }
};
template <class Epi, class Sched, bool ALIGN_EPI = false, bool SP2 = false>
__device__ __forceinline__ void gemm_phase(PG8_LAS unsigned char* lds, const Gemm g, const Sched& S, const Epi& E) {
    int tid = threadIdx.x; asm volatile("" : "+v"(tid));
    const int wid = __builtin_amdgcn_readfirstlane(tid >> 6), lane = tid & 63, wr = wid >> 2, wc = wid & 3, fr = lane & 15, fq = lane >> 4;
    const int K = g.K, nt = K / BK;
    unsigned voffA[2], voffB[2];
#pragma unroll
    for (int i = 0; i < 2; ++i) { int R, C; stage_rc(tid * 16 + i * 8192, R, C); const int Rb = Epi::PERM ? ((R & ~31) + perm32(R & 31)) : R;
        voffA[i] = (unsigned)(R * K + C) * 2u; voffB[i] = (unsigned)(Rb * K + C) * 2u; }
    const size_t kstep = (size_t)(BK * 2);
    const size_t hstep = (size_t)HALF * K * 2;
    const size_t tstep = 2 * hstep;
    const unsigned ldsw = (unsigned)wid * 1024u;
    const int aoff = lds_byte(wr * 64 + fr, fq * 8), boff = lds_byte(wc * 32 + fr, fq * 8);
#define PG8_SA(b, h) (((b) * 2 + (h)) * HTB)
#define PG8_SB(b, h) ((4 + (b) * 2 + (h)) * HTB)
#define PG8_STAGE(bufoff, gbase, voff) do { _Pragma("unroll") for (int _i = 0; _i < 2; ++_i) \
        __builtin_amdgcn_global_load_lds((const unsigned*)((const char*)(gbase) + (voff)[_i]), (PG8_LAS unsigned*)(lds + (bufoff) + ldsw + _i * 8192), 16, 0, 0); } while (0)
#define PG8_LDA(dst, b, h) do { _Pragma("unroll") for (int m = 0; m < 4; ++m) _Pragma("unroll") for (int k = 0; k < 2; ++k) dst[m][k] = *(const PG8_LAS bf16x8*)(lds + PG8_SA(b, h) + aoff + m * 2048 + k * 1024); } while (0)
#define PG8_LDB(dst, b, h) do { _Pragma("unroll") for (int n = 0; n < 2; ++n) _Pragma("unroll") for (int k = 0; k < 2; ++k) dst[n][k] = *(const PG8_LAS bf16x8*)(lds + PG8_SB(b, h) + boff + n * 2048 + k * 1024); } while (0)
#define PG8_MMA(ai, bj, At, Bt) do { __builtin_amdgcn_s_setprio(1); _Pragma("unroll") for (int m = 0; m < 4; ++m) _Pragma("unroll") for (int n = 0; n < 2; ++n) _Pragma("unroll") for (int k = 0; k < 2; ++k) \
        acc[ai][bj][m][n] = __builtin_amdgcn_mfma_f32_16x16x32_f16(Bt[n][k], At[m][k], acc[ai][bj][m][n], 0, 0, 0); __builtin_amdgcn_s_setprio(0); } while (0)
#define PG8_WAIT_V(n) asm volatile("s_waitcnt vmcnt(" #n ")" ::: "memory")
#define PG8_WAIT_L(n) asm volatile("s_waitcnt lgkmcnt(" #n ")" ::: "memory")
#define PG8_BAR __builtin_amdgcn_s_barrier()
#define PG8_SCHED __builtin_amdgcn_sched_barrier(0)
    Unit cur, nxt; int ui = 0;
    if (!S.next(0, cur)) return;
    f32x4 acc[2][2][4][2];
#pragma unroll
    for (int a = 0; a < 2; ++a)
#pragma unroll
        for (int b = 0; b < 2; ++b)
#pragma unroll
            for (int m = 0; m < 4; ++m)
#pragma unroll
                for (int n = 0; n < 2; ++n) acc[a][b][m][n] = (f32x4){0.f, 0.f, 0.f, 0.f};
    bf16x8 At[4][2], B0[2][2], B1[2][2];
    const char* cA = (const char*)g.A + (size_t)cur.pm * tstep; const char* cB = (const char*)g.Bt + (size_t)cur.pn * tstep;
    S.a_ready(cur);
    if constexpr (SP2) {
        PG8_STAGE(PG8_SB(0, 0), cB, voffB); PG8_STAGE(PG8_SB(0, 1), cB + hstep, voffB); PG8_STAGE(PG8_SA(0, 0), cA, voffA); PG8_STAGE(PG8_SA(0, 1), cA + hstep, voffA);
        if (wr == 1) PG8_BAR;
        PG8_WAIT_V(2); PG8_BAR;
        PG8_STAGE(PG8_SB(1, 0), cB + kstep, voffB); PG8_STAGE(PG8_SA(1, 0), cA + kstep, voffA); PG8_STAGE(PG8_SB(1, 1), cB + hstep + kstep, voffB);
        PG8_WAIT_V(6); PG8_BAR;
    } else {
        PG8_STAGE(PG8_SB(0, 0), cB, voffB); PG8_STAGE(PG8_SA(0, 0), cA, voffA); PG8_STAGE(PG8_SB(0, 1), cB + hstep, voffB); PG8_STAGE(PG8_SA(0, 1), cA + hstep, voffA);
        if (wr == 1) PG8_BAR;
        PG8_WAIT_V(4); PG8_BAR;
        PG8_STAGE(PG8_SB(1, 0), cB + kstep, voffB); PG8_STAGE(PG8_SA(1, 0), cA + kstep, voffA); PG8_STAGE(PG8_SB(1, 1), cB + hstep + kstep, voffB);
        PG8_WAIT_V(6); PG8_BAR;
    }
    for (;;) {
        const bool has_next = S.next(ui + 1, nxt);
        const char* nA = has_next ? (const char*)g.A + (size_t)nxt.pm * tstep : cA; const char* nB = has_next ? (const char*)g.Bt + (size_t)nxt.pn * tstep : cB;
        for (int t = 0; t < nt; t += 2) {
            const bool last = (t == nt - 2);
            const char* a1 = cA + (size_t)(t + 1) * kstep;
            const char* a2 = last ? nA : cA + (size_t)(t + 2) * kstep; const char* b2 = last ? nB : cB + (size_t)(t + 2) * kstep;
            const char* a3 = a2 + kstep; const char* b3 = b2 + kstep;
            if (last && has_next) S.a_ready(nxt);
            if constexpr (SP2) {
            PG8_LDB(B0, 0, 0); PG8_LDB(B1, 0, 1); PG8_SCHED; PG8_LDA(At, 0, 0); PG8_STAGE(PG8_SA(1, 1), a1 + hstep, voffA);
            PG8_WAIT_V(8); PG8_WAIT_L(0); PG8_BAR; PG8_MMA(0, 0, At, B0); PG8_MMA(0, 1, At, B1); PG8_BAR; PG8_SCHED;
            PG8_LDA(At, 0, 1); PG8_STAGE(PG8_SB(0, 0), b2, voffB); PG8_STAGE(PG8_SB(0, 1), b2 + hstep, voffB); PG8_STAGE(PG8_SA(0, 0), a2, voffA);
            PG8_WAIT_V(8); PG8_WAIT_L(0); PG8_BAR; PG8_MMA(1, 0, At, B0); PG8_MMA(1, 1, At, B1); PG8_BAR; PG8_SCHED;
            PG8_LDB(B0, 1, 0); PG8_LDB(B1, 1, 1); PG8_SCHED; PG8_LDA(At, 1, 0); PG8_STAGE(PG8_SA(0, 1), a2 + hstep, voffA);
            PG8_WAIT_V(8); PG8_WAIT_L(0); PG8_BAR; PG8_MMA(0, 0, At, B0); PG8_MMA(0, 1, At, B1); PG8_BAR; PG8_SCHED;
            PG8_LDA(At, 1, 1); PG8_STAGE(PG8_SB(1, 0), b3, voffB); PG8_STAGE(PG8_SB(1, 1), b3 + hstep, voffB); PG8_STAGE(PG8_SA(1, 0), a3, voffA);
            PG8_WAIT_V(8); PG8_WAIT_L(0); PG8_BAR; PG8_MMA(1, 0, At, B0); PG8_MMA(1, 1, At, B1); PG8_BAR; PG8_SCHED;
            } else {
            PG8_LDB(B0, 0, 0); PG8_SCHED; PG8_LDA(At, 0, 0); PG8_STAGE(PG8_SA(1, 1), a1 + hstep, voffA);
            PG8_WAIT_L(8); PG8_BAR; PG8_WAIT_L(0); PG8_MMA(0, 0, At, B0); PG8_BAR; PG8_SCHED;
            PG8_LDB(B1, 0, 1); PG8_STAGE(PG8_SB(0, 0), b2, voffB);
            PG8_BAR; PG8_WAIT_L(0); PG8_MMA(0, 1, At, B1); PG8_BAR;
            PG8_LDA(At, 0, 1); PG8_STAGE(PG8_SA(0, 0), a2, voffA);
            PG8_BAR; PG8_WAIT_L(0); PG8_MMA(1, 0, At, B0); PG8_BAR; PG8_SCHED;
            PG8_STAGE(PG8_SB(0, 1), b2 + hstep, voffB);
            PG8_WAIT_V(6); PG8_BAR; PG8_MMA(1, 1, At, B1); PG8_BAR;
            PG8_LDB(B0, 1, 0); PG8_SCHED; PG8_LDA(At, 1, 0); PG8_STAGE(PG8_SA(0, 1), a2 + hstep, voffA);
            PG8_WAIT_L(8); PG8_BAR; PG8_WAIT_L(0); PG8_MMA(0, 0, At, B0); PG8_BAR; PG8_SCHED;
            PG8_LDB(B1, 1, 1); PG8_STAGE(PG8_SB(1, 0), b3, voffB);
            PG8_BAR; PG8_WAIT_L(0); PG8_MMA(0, 1, At, B1); PG8_BAR;
            PG8_LDA(At, 1, 1); PG8_STAGE(PG8_SA(1, 0), a3, voffA);
            PG8_BAR; PG8_WAIT_L(0); PG8_MMA(1, 0, At, B0); PG8_BAR; PG8_SCHED;
            PG8_STAGE(PG8_SB(1, 1), b3 + hstep, voffB);
            PG8_WAIT_V(6); PG8_BAR; PG8_MMA(1, 1, At, B1); PG8_BAR;
            }
        }
        if constexpr (ALIGN_EPI) { if (wr == 0) PG8_BAR; }
        if constexpr (!Epi::AFTER_DRAIN) { E(acc, cur, wr, wc, fr, fq); S.done(cur); }
        if (!has_next) break;
#pragma unroll
        for (int a = 0; a < 2; ++a)
#pragma unroll
            for (int b = 0; b < 2; ++b)
#pragma unroll
                for (int m = 0; m < 4; ++m)
#pragma unroll
                    for (int n = 0; n < 2; ++n) acc[a][b][m][n] = (f32x4){0.f, 0.f, 0.f, 0.f};
        cur = nxt; cA = nA; cB = nB; ++ui;
        if constexpr (ALIGN_EPI) { if (wr == 1) PG8_BAR; }
    }
    PG8_WAIT_V(0);
    if constexpr (!ALIGN_EPI) { if (wr == 0) PG8_BAR; }
    PG8_BAR;
    if constexpr (Epi::AFTER_DRAIN) { E.fused(acc, cur, wr, wc, fr, fq, lds, wid, lane); S.done(cur); }
#undef PG8_SA
#undef PG8_SB
#undef PG8_STAGE
#undef PG8_LDA
#undef PG8_LDB
#undef PG8_MMA
#undef PG8_WAIT_V
#undef PG8_WAIT_L
#undef PG8_BAR
#undef PG8_SCHED
}
}
namespace att {
constexpr int D = 128, NW = 8, QBLK = 32, KVBLK = 64;
constexpr float SCALE = 0.088388347648318440f;
constexpr float THR = 8.f;
constexpr int SHM_V = KVBLK * D * 2, SHM_K = KVBLK * D * 2, SHM_ATTN = 2 * SHM_V + 2 * SHM_K + NW * 64 * 4;
#define KSWZ(row, colB) ((row) * 256 + ((colB) ^ (((row) & 7) << 4)))
#define SBAR() __builtin_amdgcn_sched_barrier(0)
__device__ __forceinline__ int crow(int r, int hi) { return (r & 3) + 8 * (r >> 2) + 4 * hi; }

__device__ __forceinline__ void partialSM(f32x16& p0, f32x16& p1, float& m_reg, float& mn, float& alpha) {
  constexpr float C = SCALE * 1.4426950408889634f;
  float pmax = p0[0];
#pragma unroll
  for (int r = 1; r < 16; ++r) pmax = fmaxf(pmax, p0[r]);
#pragma unroll
  for (int r = 0; r < 16; ++r) pmax = fmaxf(pmax, p1[r]);
  { auto rr = __builtin_amdgcn_permlane32_swap(__float_as_uint(pmax), __float_as_uint(pmax), false, false);
    pmax = fmaxf(__uint_as_float(rr[0]), __uint_as_float(rr[1])); }
  if (__builtin_expect(__all(pmax - m_reg <= THR / SCALE), 1)) { mn = m_reg; alpha = 1.f; }
  else { mn = fmaxf(m_reg, pmax); alpha = __builtin_amdgcn_exp2f((m_reg - mn) * C); m_reg = mn; }
  float mnC = -mn * C;
#pragma unroll
  for (int r = 0; r < 16; ++r) p0[r] = fmaf(p0[r], C, mnC);
#pragma unroll
  for (int r = 0; r < 16; ++r) p1[r] = fmaf(p1[r], C, mnC);
#pragma unroll
  for (int r = 0; r < 16; ++r) p0[r] = __builtin_amdgcn_exp2f(p0[r]);
}
__device__ __forceinline__ void finishSM(f32x16& p0, f32x16& p1, float alpha, float& l_reg, hx8& pa0, hx8& pa1, hx8& pa2, hx8& pa3) {
#pragma unroll
  for (int r = 0; r < 16; ++r) p1[r] = __builtin_amdgcn_exp2f(p1[r]);
  float ps = 0;
#pragma unroll
  for (int r = 0; r < 16; ++r) ps += p0[r];
#pragma unroll
  for (int r = 0; r < 16; ++r) ps += p1[r];
  { auto rr = __builtin_amdgcn_permlane32_swap(__float_as_uint(ps), __float_as_uint(ps), false, false);
    ps = __uint_as_float(rr[0]) + __uint_as_float(rr[1]); }
  l_reg = l_reg * alpha + ps;
#define PK4(P, BASE, OUT) do { unsigned a0 = pkh(P[BASE + 0], P[BASE + 1]), a1 = pkh(P[BASE + 2], P[BASE + 3]);   \
    unsigned b0 = pkh(P[BASE + 4], P[BASE + 5]), b1 = pkh(P[BASE + 6], P[BASE + 7]);                              \
    auto r0 = __builtin_amdgcn_permlane32_swap(a0, b0, false, false); auto r1 = __builtin_amdgcn_permlane32_swap(a1, b1, false, false); \
    u32x4 w = {r0[0], r1[0], r0[1], r1[1]}; OUT = __builtin_bit_cast(hx8, w); } while (0)
  PK4(p0, 0, pa0); PK4(p0, 8, pa1); PK4(p1, 0, pa2); PK4(p1, 8, pa3);
#undef PK4
}
template <bool QLDS>
__device__ __forceinline__ void qkt(f32x16& p0, f32x16& p1, const LAS char* Ks, const hx8* qr, const LAS char* qlds, int r32, int hi) {
  p0 = f32x16{}; p1 = f32x16{};
  const int B = (r32 * 256 + ((hi * 16) ^ ((r32 & 1) << 4))) | (((r32 >> 1) & 3) << 5);
#pragma unroll
  for (int d0 = 0; d0 < 8; ++d0) { const LAS char* kp = Ks + (B ^ ((d0 & 3) << 5)) + (d0 >> 2) * 128;
    hx8 b0 = *(const LAS hx8*)kp;
    hx8 b1 = *(const LAS hx8*)(kp + 8192);
    const hx8 q = QLDS ? *(const LAS hx8*)(qlds + d0 * 1024) : qr[d0];
    p0 = __builtin_amdgcn_mfma_f32_32x32x16_f16(b0, q, p0, 0, 0, 0);
    p1 = __builtin_amdgcn_mfma_f32_32x32x16_f16(b1, q, p1, 0, 0, 0); }
}
__device__ __forceinline__ void wmask(f32x16& p0, f32x16& p1, int dq, int hi) {
#pragma unroll
  for (int r = 0; r < 16; ++r) { const int d0 = dq - crow(r, hi), d1 = d0 - 32;
    if (d0 > 128 || d0 < -128) p0[r] = -1e30f;
    if (d1 > 128 || d1 < -128) p1[r] = -1e30f; }
}
__device__ __forceinline__ int v_st(int k, int c) { const int kk = (k & ~0xC) | ((k & 4) << 1) | ((k & 8) >> 1); return ((kk >> 3) * 4 + (c >> 5)) * 512 + ((kk & 7) * 32 + (c & 31)) * 2; }
__device__ __forceinline__ int v_rd_base(int lane) { return ((lane & 3) << 3) | (((lane >> 2) & 3) << 6) | (((lane >> 4) & 1) << 5) | (((lane >> 5) & 1) << 8); }
constexpr int v_rd_off(int d0, int ks, int half) { return d0 * 512 + ks * 4096 + half * 2048; }
template <int OFF> __device__ __forceinline__ s16x4 tr_read(int vb) {
  s16x4 r; asm volatile("ds_read_b64_tr_b16 %0, %1 offset:%2" : "=&v"(r) : "v"(vb), "i"(OFF) : "memory"); return r;
}
template <int D0> __device__ __forceinline__ void pv_one(f32x16& od, int vb, hx8 pa0, hx8 pa1, hx8 pa2, hx8 pa3) {
  const s16x4 l0 = tr_read<v_rd_off(D0, 0, 0)>(vb), h0 = tr_read<v_rd_off(D0, 0, 1)>(vb), l1 = tr_read<v_rd_off(D0, 1, 0)>(vb), h1 = tr_read<v_rd_off(D0, 1, 1)>(vb);
  const s16x4 l2 = tr_read<v_rd_off(D0, 2, 0)>(vb), h2 = tr_read<v_rd_off(D0, 2, 1)>(vb), l3 = tr_read<v_rd_off(D0, 3, 0)>(vb), h3 = tr_read<v_rd_off(D0, 3, 1)>(vb);
  asm volatile("s_waitcnt lgkmcnt(0)" ::: "memory"); SBAR();
#define PK(L, H) __builtin_bit_cast(hx8, (s16x8){L[0], L[1], L[2], L[3], H[0], H[1], H[2], H[3]})
  od = __builtin_amdgcn_mfma_f32_32x32x16_f16(pa0, PK(l0, h0), od, 0, 0, 0);
  od = __builtin_amdgcn_mfma_f32_32x32x16_f16(pa1, PK(l1, h1), od, 0, 0, 0);
  od = __builtin_amdgcn_mfma_f32_32x32x16_f16(pa2, PK(l2, h2), od, 0, 0, 0);
  od = __builtin_amdgcn_mfma_f32_32x32x16_f16(pa3, PK(l3, h3), od, 0, 0, 0);
#undef PK
}
__device__ __forceinline__ void pv_d0(f32x16* o, int vb, hx8 pa0, hx8 pa1, hx8 pa2, hx8 pa3) {
  pv_one<0>(o[0], vb, pa0, pa1, pa2, pa3); pv_one<1>(o[1], vb, pa0, pa1, pa2, pa3); pv_one<2>(o[2], vb, pa0, pa1, pa2, pa3); pv_one<3>(o[3], vb, pa0, pa1, pa2, pa3);
}

template <bool WIN, int LD, int SD>
__device__ __forceinline__ void attn_unit(const u16* __restrict__ Qb, const u16* __restrict__ Kh, const u16* __restrict__ Vh, const u16* __restrict__ Gb,
                                          u16* __restrict__ Yb, int NT, const float* __restrict__ sinkp, int dq0, LAS char* lds,
                                          const float* __restrict__ qn, const f32x2* __restrict__ tabA, const f32x2* __restrict__ tabB_, int t0) {
  constexpr int LDK = 128;
  int tid = threadIdx.x; asm volatile("" : "+v"(tid));
  const int wid = tid >> 6, lane = tid & 63, r32 = lane & 31, hi = lane >> 5;
  LAS char* V_lds = lds; LAS char* K_lds = lds + 2 * SHM_V;
  LAS float* ws = (LAS float*)(lds + 2 * SHM_V + 2 * SHM_K) + wid * 64; LAS float* li_l = ws; LAS float* al_l = ws + 32;
  const int wrow = WIN ? (wid & 3) * QBLK : wid * QBLK, hcol = WIN ? (wid >> 2) * 128 : 0;
  LAS char* qlds = lds + SHM_ATTN + wid * 8192 + lane * 16;
  float m_reg = WIN ? sinkp[wid >> 2] * (1.0f / SCALE) : -1e30f, l_reg = WIN ? 1.0f : 0.f; f32x16 o[4] = {}; hx8 qr[8];
  const u16* Qw = Qb + hcol + (long)(wrow + r32) * LD + hi * 8;
  const int sr = tid >> 4, sc = (tid & 15) * 8, vst0 = v_st(sr, sc), ksw0 = KSWZ(sr, sc * 2);
  const int vb0 = (int)(uintptr_t)V_lds + v_rd_base(lane);
  const int dqw = dq0 + wrow + r32;
  struct { hx8 vs0, vs1, ks0, ks1; } sr_[SD];
#define SLOAD(i, k0) do { sr_[i].vs0 = *(const hx8*)(&Vh[(long)((k0) + sr) * LDK + sc]); sr_[i].vs1 = *(const hx8*)(&Vh[(long)((k0) + 32 + sr) * LDK + sc]); \
    sr_[i].ks0 = *(const hx8*)(&Kh[(long)((k0) + sr) * LDK + sc]); sr_[i].ks1 = *(const hx8*)(&Kh[(long)((k0) + 32 + sr) * LDK + sc]); } while (0)
#define SWRITE(b, i) do { *(LAS hx8*)(V_lds + (b) * SHM_V + vst0) = sr_[i].vs0;          \
    *(LAS hx8*)(V_lds + (b) * SHM_V + vst0 + 8192) = sr_[i].vs1;                          \
    *(LAS hx8*)(K_lds + (b) * SHM_K + ksw0) = sr_[i].ks0;                                \
    *(LAS hx8*)(K_lds + (b) * SHM_K + ksw0 + 8192) = sr_[i].ks1; } while (0)
#define SWAIT() do { if (SD == 2) asm volatile("s_waitcnt vmcnt(4)" ::: "memory"); else asm volatile("s_waitcnt vmcnt(0)" ::: "memory"); } while (0)
#define RESC(a) do { if (__any((a) < 1.f)) { if (hi == 0) al_l[r32] = (a); asm volatile("s_waitcnt lgkmcnt(0)" ::: "memory"); \
    _Pragma("unroll") for (int d = 0; d < 4; ++d) _Pragma("unroll") for (int r = 0; r < 16; ++r) o[d][r] *= al_l[crow(r, hi)]; } } while (0)
  constexpr int SE = 0, SO = SD - 1;
  SLOAD(SE, 0);
  {
    float y[8][8]; float ss = 0.f;
#pragma unroll
    for (int d0 = 0; d0 < 8; ++d0) { const hx8 v = *(const hx8*)(Qw + d0 * 16);
#pragma unroll
      for (int j = 0; j < 8; ++j) { y[d0][j] = (float)v[j]; ss += y[d0][j] * y[d0][j]; } }
    { auto rr = __builtin_amdgcn_permlane32_swap(__float_as_uint(ss), __float_as_uint(ss), false, false); ss = __uint_as_float(rr[0]) + __uint_as_float(rr[1]); }
    const float rstd = 1.0f / sqrtf(ss * (1.f / 128.f) + 1e-6f);
#pragma unroll
    for (int d0 = 0; d0 < 8; ++d0) { const f32x4 g0 = *(const f32x4*)(qn + d0 * 16 + hi * 8), g1 = *(const f32x4*)(qn + d0 * 16 + hi * 8 + 4);
#pragma unroll
      for (int j = 0; j < 4; ++j) { y[d0][j] *= rstd * g0[j]; y[d0][4 + j] *= rstd * g1[j]; } }
    const int t = t0 + wrow + r32;
    if (WIN) {
      const f32x4* tp = (const f32x4*)(tabA + t * 16 + hi * 8);
#pragma unroll
      for (int j2 = 0; j2 < 4; ++j2) { const f32x4 cs = tp[j2];
        { const float x1 = y[0][2 * j2], x2 = y[1][2 * j2]; y[0][2 * j2] = x1 * cs.x - x2 * cs.y; y[1][2 * j2] = x2 * cs.x + x1 * cs.y; }
        { const float x1 = y[0][2 * j2 + 1], x2 = y[1][2 * j2 + 1]; y[0][2 * j2 + 1] = x1 * cs.z - x2 * cs.w; y[1][2 * j2 + 1] = x2 * cs.z + x1 * cs.w; } }
    } else {
#pragma unroll
      for (int hf = 0; hf < 2; ++hf)
#pragma unroll
        for (int dd = 0; dd < 2; ++dd) { const int da = hf * 4 + dd, db = da + 2;
          const f32x4* tp = (const f32x4*)((hf == 0 ? tabA + (t >> 6) * 32 : tabB_ + (t & 63) * 32) + dd * 16 + hi * 8);
#pragma unroll
          for (int j2 = 0; j2 < 4; ++j2) { const f32x4 cs = tp[j2];
            { const float x1 = y[da][2 * j2], x2 = y[db][2 * j2]; y[da][2 * j2] = x1 * cs.x - x2 * cs.y; y[db][2 * j2] = x2 * cs.x + x1 * cs.y; }
            { const float x1 = y[da][2 * j2 + 1], x2 = y[db][2 * j2 + 1]; y[da][2 * j2 + 1] = x1 * cs.z - x2 * cs.w; y[db][2 * j2 + 1] = x2 * cs.z + x1 * cs.w; } } }
    }
#pragma unroll
    for (int d0 = 0; d0 < 8; ++d0) { u32x4 w = {pkh(y[d0][0], y[d0][1]), pkh(y[d0][2], y[d0][3]), pkh(y[d0][4], y[d0][5]), pkh(y[d0][6], y[d0][7])}; qr[d0] = __builtin_bit_cast(hx8, w);
      if (WIN) *(LAS hx8*)(qlds + d0 * 1024) = qr[d0]; }
  }
  f32x16 pA0, pA1, pB0, pB1; float mnA, mnB, alA, alB; hx8 pa0, pa1, pa2, pa3;
  asm volatile("s_waitcnt vmcnt(0)" ::: "memory"); SWRITE(0, SE); __syncthreads();
  qkt<WIN>(pA0, pA1, K_lds, qr, qlds, r32, hi); if (WIN) wmask(pA0, pA1, dqw, hi); partialSM(pA0, pA1, m_reg, mnA, alA);
  SLOAD(SO, KVBLK); if (SD == 2) { if (2 < NT) SLOAD(SE, 2 * KVBLK); }
  SWAIT(); SWRITE(1, SO); __syncthreads();
  for (int j = 1; j + 1 < NT; j += 2) {
    SBAR(); qkt<WIN>(pB0, pB1, K_lds + SHM_K, qr, qlds, r32, hi); if (WIN) wmask(pB0, pB1, dqw - j * KVBLK, hi);
    finishSM(pA0, pA1, alA, l_reg, pa0, pa1, pa2, pa3); SBAR();
    SLOAD(SO, (j + SD) * KVBLK); SBAR();
    pv_d0(o, vb0, pa0, pa1, pa2, pa3); partialSM(pB0, pB1, m_reg, mnB, alB);
    __syncthreads(); SWAIT(); SWRITE(0, SE);
    RESC(alB); __syncthreads();
    SBAR(); qkt<WIN>(pA0, pA1, K_lds, qr, qlds, r32, hi); if (WIN) wmask(pA0, pA1, dqw - (j + 1) * KVBLK, hi);
    finishSM(pB0, pB1, alB, l_reg, pa0, pa1, pa2, pa3); SBAR();
    if (SD == 1 || j + 3 < NT) SLOAD(SE, (j + 1 + SD) * KVBLK); SBAR();
    pv_d0(o, vb0 + SHM_V, pa0, pa1, pa2, pa3); partialSM(pA0, pA1, m_reg, mnA, alA);
    __syncthreads(); SWAIT(); SWRITE(1, SO);
    RESC(alA); __syncthreads();
  }
  const u16* Gw = Gb + hcol + (long)wrow * LD; const int erow = lane >> 4, ech = (lane & 15) * 8;
  hx8 gpre[8];
#pragma unroll
  for (int it = 0; it < 8; ++it) gpre[it] = *(const hx8*)(Gw + (long)(it * 4 + erow) * LD + ech);
  SBAR(); qkt<WIN>(pB0, pB1, K_lds + SHM_K, qr, qlds, r32, hi); if (WIN) wmask(pB0, pB1, dqw - (NT - 1) * KVBLK, hi);
  finishSM(pA0, pA1, alA, l_reg, pa0, pa1, pa2, pa3); SBAR();
  pv_d0(o, vb0, pa0, pa1, pa2, pa3); partialSM(pB0, pB1, m_reg, mnB, alB);
  __syncthreads(); RESC(alB);
  finishSM(pB0, pB1, alB, l_reg, pa0, pa1, pa2, pa3); SBAR();
  pv_d0(o, vb0 + SHM_V, pa0, pa1, pa2, pa3);
  if (hi == 0) li_l[r32] = l_reg; asm volatile("s_waitcnt lgkmcnt(0)" ::: "memory");
  float rli[16];
#pragma unroll
  for (int r = 0; r < 16; ++r) rli[r] = __builtin_amdgcn_rcpf(li_l[crow(r, hi)]);
  LAS u16* img = (LAS u16*)(lds + SHM_ATTN + wid * 8192);
#pragma unroll
  for (int r = 0; r < 16; ++r) { const int orow = crow(r, hi);
#pragma unroll
    for (int d0 = 0; d0 < 4; ++d0) img[orow * 128 + d0 * 32 + r32] = f2h(o[d0][r] * rli[r]); }
  u16* Yw = Yb + hcol + (long)wrow * DM;
#pragma unroll
  for (int it = 0; it < 8; ++it) { const int row = it * 4 + erow;
    const hx8 ov = *(const LAS hx8*)(img + row * 128 + ech), gv = gpre[it];
    u32x4 w = {pkh((float)ov[0] * (float)gv[0], (float)ov[1] * (float)gv[1]), pkh((float)ov[2] * (float)gv[2], (float)ov[3] * (float)gv[3]),
               pkh((float)ov[4] * (float)gv[4], (float)ov[5] * (float)gv[5]), pkh((float)ov[6] * (float)gv[6], (float)ov[7] * (float)gv[7])};
    *(u32x4*)(Yw + (long)row * DM + ech) = w; }
#undef SLOAD
#undef SWRITE
#undef SWAIT
#undef RESC
}
}

constexpr size_t MiB = 1u << 20;
constexpr size_t WS_WIN_AB = 0, WS_WOUT_AB = 44 * MiB, WS_WIN_C = 60 * MiB, WS_WOUT_C = 100 * MiB, WS_TAB = 116 * MiB;
constexpr size_t WS_BAR = WS_TAB + 1 * MiB + 64 * 1024, BAR_BYTES = 16384;
constexpr size_t WS_SSQ = WS_TAB + 1 * MiB + 256 * 1024;
constexpr size_t WS_TABB = WS_TAB, WS_TABR = WS_TAB + 1 * MiB, WS_TABC = WS_TABR + 32768;
constexpr size_t WS_H = 118 * MiB, WS_Y = 278 * MiB, WS_Z = 438 * MiB, WS_KV = 878 * MiB, WS_END = 962 * MiB;
static_assert((size_t)2 * AB_IN * DM * 2 <= 44 * MiB && (size_t)2 * C_IN * DM * 2 <= 40 * MiB && (size_t)MTOK * DM * 2 <= 160 * MiB && (size_t)MTOK * AB_IN * 2 <= 440 * MiB, "ws map");
constexpr int LDS_BYTES = 151552;
constexpr int NPHASE = 17;

struct Args { const float* in[16]; float* out; unsigned char* ws; int ph_lo, ph_hi; };

__device__ __forceinline__ void p0_transpose_item(const float* W, const float* gain, int K, int N, u16* WT, LAS float* scr, int item, int lane) {
    const int nblk = N / 32, kb = item / nblk, nb = item % nblk, k0 = 64 * kb, n0 = 32 * nb;
    float wv[32];
#pragma unroll
    for (int i = 0; i < 32; ++i) { const int kk = 2 * i + (lane >> 5); wv[i] = __builtin_nontemporal_load(W + (size_t)(k0 + kk) * N + n0 + (lane & 31)); }
    const float g0 = gain ? gain[k0 + lane] : 1.0f;
#pragma unroll
    for (int i = 0; i < 32; ++i) { const int kk = 2 * i + (lane >> 5); scr[kk * 33 + (lane & 31)] = wv[i] * __shfl(g0, kk); }
    asm volatile("s_waitcnt lgkmcnt(0)" ::: "memory");
    const int c = lane & 7;
#pragma unroll
    for (int j = 0; j < 4; ++j) { const int n = (lane >> 3) + 8 * j; const LAS float* s = scr + (8 * c) * 33 + n;
        u32x4 o; o.x = pkh(s[0 * 33], s[1 * 33]); o.y = pkh(s[2 * 33], s[3 * 33]); o.z = pkh(s[4 * 33], s[5 * 33]); o.w = pkh(s[6 * 33], s[7 * 33]);
        *(u32x4*)(WT + (size_t)(n0 + n) * K + k0 + 8 * c) = o; }
    asm volatile("s_waitcnt lgkmcnt(0)" ::: "memory");
}
__device__ __forceinline__ void sincos_d(double a, float& s, float& c) {
    double rev = a * 0.15915494309189533577; rev -= __builtin_rint(rev); const double r = rev * 6.283185307179586476925, r2 = r * r;
    double ss = 1.0, cc = 1.0;
#pragma unroll
    for (int k = 12; k >= 1; --k) { ss = 1.0 - ss * r2 / (double)((2 * k) * (2 * k + 1)); cc = 1.0 - cc * r2 / (double)((2 * k - 1) * (2 * k)); }
    s = (float)(ss * r); c = (float)cc;
}
__device__ __forceinline__ void rope_tables(unsigned char* ws, int gtid, int gthreads) {
    const double bB = __builtin_sqrt(__builtin_sqrt(__builtin_sqrt(__builtin_sqrt(1.0 / 500000.0))));
    const double bC = __builtin_sqrt(__builtin_sqrt(__builtin_sqrt(__builtin_sqrt(__builtin_sqrt(1.0 / 10000.0)))));
    f32x2* tB = (f32x2*)(ws + WS_TABB); f32x2* tR = (f32x2*)(ws + WS_TABR); f32x2* tC = (f32x2*)(ws + WS_TABC);
    for (int e = gtid; e < 8192 * 16 + 128 * 32 + 64 * 32; e += gthreads) {
        int pos, i; double base; f32x2* dst;
        if (e < 8192 * 16) { pos = e >> 4; i = e & 15; base = bB; dst = tB + e; }
        else if (e < 8192 * 16 + 128 * 32) { const int f = e - 8192 * 16; pos = f >> 5; i = f & 31; base = bC; dst = tR + f; }
        else { const int f = e - 8192 * 16 - 128 * 32; pos = f >> 5; i = f & 31; base = bC; dst = tC + f; }
        double inv = 1.0; for (int k = 0; k < i; ++k) inv *= base;
        const float invf = (float)inv; const float ang = (float)pos * invf;
        float s, c; sincos_d((double)ang, s, c); *dst = (f32x2){c, s};
    }
}
__device__ __forceinline__ void cvt_phase(const float* x0, const float* x1, u16* H, float* ssq, int gw, int ngw, int lane) {
    for (int m = gw; m < MTOK; m += ngw) {
        const f32x4* xr = (const f32x4*)((m < NTOK_P ? x0 : x1) + (size_t)m * DM) + lane;
        f32x4 v[8]; float s = 0.f;
#pragma unroll
        for (int j = 0; j < 8; ++j) { v[j] = xr[64 * j]; s += (v[j].x * v[j].x + v[j].y * v[j].y) + (v[j].z * v[j].z + v[j].w * v[j].w); }
        s = wave_sum(s); if (lane == 0) ssq[m] = s;
        u32x2* o8 = (u32x2*)(H + (size_t)m * DM) + lane;
#pragma unroll
        for (int j = 0; j < 8; ++j) o8[64 * j] = (u32x2){pkh(v[j].x, v[j].y), pkh(v[j].z, v[j].w)};
    }
}
template <bool ODD>
__device__ __forceinline__ void prep_phase(u16* KV, const float* kn, const unsigned char* ws, int gw, int ngw, int lane) {
    constexpr int NKH = ODD ? 4 : 2;
    const f32x2* tB = (const f32x2*)(ws + WS_TABB); const f32x2* tR = (const f32x2*)(ws + WS_TABR); const f32x2* tC = (const f32x2*)(ws + WS_TABC);
    const int sub = lane >> 4, ls = lane & 15;
    const f32x4 g0 = *(const f32x4*)(kn + ls * 8), g1 = *(const f32x4*)(kn + ls * 8 + 4);
    constexpr int NB = 5;
    for (int it0 = gw; it0 < MTOK * NKH / 4; it0 += NB * ngw) {
        hx8 vv[NB];
#pragma unroll
        for (int b = 0; b < NB; ++b) { const int it = it0 + b * ngw; if (it < MTOK * NKH / 4) vv[b] = *(const hx8*)(KV + (size_t)(it * 4 + sub) * 128 + ls * 8); }
#pragma unroll
        for (int b = 0; b < NB; ++b) { const int it = it0 + b * ngw; if (it >= MTOK * NKH / 4) break;
        const int R = it * 4 + sub, kh = R / MTOK, row = R - kh * MTOK;
        const int t = row < NTOK_P ? (row & (SEQ_P - 1)) : ((row - NTOK_P) & (SEQ_S - 1));
        u16* p = KV + (size_t)R * 128 + ls * 8;
        const hx8 v = vv[b]; float y[8]; float ss = 0.f;
#pragma unroll
        for (int j = 0; j < 8; ++j) { y[j] = (float)v[j]; ss += y[j] * y[j]; }
        ss += __shfl_xor(ss, 1); ss += __shfl_xor(ss, 2); ss += __shfl_xor(ss, 4); ss += __shfl_xor(ss, 8);
        const float rstd = 1.0f / sqrtf(ss * (1.f / 128.f) + EPS);
#pragma unroll
        for (int j = 0; j < 4; ++j) { y[j] *= rstd * g0[j]; y[4 + j] *= rstd * g1[j]; }
        if (ODD) {
            const f32x4* tp = (const f32x4*)((ls < 8 ? tR + (t >> 6) * 32 : tC + (t & 63) * 32) + (ls & 3) * 8);
            const bool second = (ls & 4) != 0;
#pragma unroll
            for (int j2 = 0; j2 < 4; ++j2) { const f32x4 cs = tp[j2];
                const float pa = __shfl_xor(y[2 * j2], 4), pb = __shfl_xor(y[2 * j2 + 1], 4);
                y[2 * j2] = y[2 * j2] * cs.x + (second ? pa : -pa) * cs.y; y[2 * j2 + 1] = y[2 * j2 + 1] * cs.z + (second ? pb : -pb) * cs.w; }
        } else {
            const f32x4* tp = (const f32x4*)(tB + t * 16 + (ls & 1) * 8);
            const bool second = (ls & 2) != 0;
#pragma unroll
            for (int j2 = 0; j2 < 4; ++j2) { const f32x4 cs = tp[j2];
                const float pa = __shfl_xor(y[2 * j2], 2), pb = __shfl_xor(y[2 * j2 + 1], 2);
                const float ya = y[2 * j2] * cs.x + (second ? pa : -pa) * cs.y, yb = y[2 * j2 + 1] * cs.z + (second ? pb : -pb) * cs.w;
                if (ls < 4) { y[2 * j2] = ya; y[2 * j2 + 1] = yb; } }
        }
        *(u32x4*)p = (u32x4){pkh(y[0], y[1]), pkh(y[2], y[3]), pkh(y[4], y[5]), pkh(y[6], y[7])};
        }
    }
}
__device__ __forceinline__ void mixer_a_phase(const u16* Z, u16* Y, const float* vnorm, const float* wsp, const float* bsp, int c, int G, LAS char* lds) {
    constexpr int PIT = 136, MP = 132, NU = (MTOK / 128) * 8;
    int tid = threadIdx.x; asm volatile("" : "+v"(tid));
    const int wid = tid >> 6, lane = tid & 63, r32 = lane & 31, hi = lane >> 5;
    LAS u16* vnT = (LAS u16*)lds; LAS float* mx = (LAS float*)(lds + 36864);
    const int q = tid >> 2, part = tid & 3, pb = wid & 3, dh = wid >> 2;
    hx8 nv[4], nu[4], ng[4];
#define MA_LOAD(unit) do { const u16* src_ = Z + (size_t)(((unit) >> 3) * 128 + q) * AB_IN + ((unit) & 7) * 128 + part * 32; \
    _Pragma("unroll") for (int j = 0; j < 4; ++j) { nv[j] = *(const hx8*)(src_ + 1024 + 8 * j); nu[j] = *(const hx8*)(src_ + 8 * j); ng[j] = *(const hx8*)(src_ + 2048 + 8 * j); } } while (0)
    int gcur = -1; hx8 af[8]; float bsv[16]; float gnv[32];
    if (c < NU) MA_LOAD(c);
    for (int ua = c; ua < NU; ua += G) {
        const int chunk = ua >> 3, g = ua & 7;
        hx8 v[4], u[4], gt[4];
#pragma unroll
        for (int j = 0; j < 4; ++j) { v[j] = nv[j]; u[j] = nu[j]; gt[j] = ng[j]; }
        if (g != gcur) {
            const float* wrow = wsp + (size_t)g * 128 * 128 + (size_t)(pb * 32 + r32) * 128 + hi * 8;
#pragma unroll
            for (int ks = 0; ks < 8; ++ks) { const f32x4 a0 = *(const f32x4*)(wrow + ks * 16), a1 = *(const f32x4*)(wrow + ks * 16 + 4);
                af[ks] = (hx8){(_Float16)a0.x, (_Float16)a0.y, (_Float16)a0.z, (_Float16)a0.w, (_Float16)a1.x, (_Float16)a1.y, (_Float16)a1.z, (_Float16)a1.w}; }
#pragma unroll
            for (int r = 0; r < 16; ++r) bsv[r] = bsp[g * 128 + pb * 32 + att::crow(r, hi)];
#pragma unroll
            for (int j = 0; j < 8; ++j) { const f32x4 t4 = *(const f32x4*)(vnorm + g * 128 + part * 32 + 4 * j); gnv[4 * j] = t4.x; gnv[4 * j + 1] = t4.y; gnv[4 * j + 2] = t4.z; gnv[4 * j + 3] = t4.w; }
            gcur = g;
        }
        { float ss = 0.f;
#pragma unroll
          for (int j = 0; j < 4; ++j)
#pragma unroll
              for (int e = 0; e < 8; ++e) { const float f = (float)v[j][e]; ss += f * f; }
          ss += __shfl_xor(ss, 1); ss += __shfl_xor(ss, 2);
          const float rstd = 1.0f / sqrtf(ss * (1.f / 128.f) + EPS);
#pragma unroll
          for (int j = 0; j < 4; ++j)
#pragma unroll
              for (int e = 0; e < 8; ++e) vnT[(part * 32 + j * 8 + e) * PIT + q] = f2h((float)v[j][e] * rstd * gnv[j * 8 + e]); }
        __syncthreads();
        if (ua + G < NU) MA_LOAD(ua + G);
        f32x16 acc0 = {}, acc1 = {};
#pragma unroll
        for (int ks = 0; ks < 8; ++ks) {
            const hx8 b0 = *(const LAS hx8*)(vnT + (dh * 64 + r32) * PIT + ks * 16 + hi * 8);
            const hx8 b1 = *(const LAS hx8*)(vnT + (dh * 64 + 32 + r32) * PIT + ks * 16 + hi * 8);
            acc0 = __builtin_amdgcn_mfma_f32_32x32x16_f16(af[ks], b0, acc0, 0, 0, 0);
            acc1 = __builtin_amdgcn_mfma_f32_32x32x16_f16(af[ks], b1, acc1, 0, 0, 0);
        }
#pragma unroll
        for (int r = 0; r < 16; ++r) { LAS float* mp = mx + (pb * 32 + att::crow(r, hi)) * MP + dh * 64 + r32; mp[0] = acc0[r] + bsv[r]; mp[32] = acc1[r] + bsv[r]; }
        __syncthreads();
        { u16* yr = Y + (size_t)(chunk * 128 + q) * DM + g * 128 + part * 32; const LAS float* mr = mx + q * MP + part * 32;
#pragma unroll
          for (int j = 0; j < 4; ++j) { const f32x4 m0 = *(const LAS f32x4*)(mr + 8 * j), m1 = *(const LAS f32x4*)(mr + 8 * j + 4);
              float o[8];
#pragma unroll
              for (int e = 0; e < 4; ++e) { o[e] = (float)u[j][e] * m0[e] * (float)gt[j][e]; o[4 + e] = (float)u[j][4 + e] * m1[e] * (float)gt[j][4 + e]; }
              *(u32x4*)(yr + 8 * j) = (u32x4){pkh(o[0], o[1]), pkh(o[2], o[3]), pkh(o[4], o[5]), pkh(o[6], o[7])}; } }
    }
    __syncthreads();
#undef MA_LOAD
}

#define XB_TMO      128
#define XB_XCNT(j)  (256  + 64 * (j))
#define XB_XSUB(j)  (1280 + 64 * (j))
#define XB_XGEN(j)  (2304 + 64 * (j))
#define XB_TOP      3328
#define XB_TOPGEN   3392
#define XCD_BAR_WORDS 3456
#define XB_SPIN_CAP (1u << 18)

__device__ __forceinline__ unsigned xb_ld(unsigned* p)              { return __hip_atomic_load(p, __ATOMIC_RELAXED, __HIP_MEMORY_SCOPE_AGENT); }
__device__ __forceinline__ unsigned xb_add(unsigned* p, unsigned v) { return __hip_atomic_fetch_add(p, v, __ATOMIC_RELAXED, __HIP_MEMORY_SCOPE_AGENT); }
__device__ __forceinline__ unsigned xb_xcc_id() { return (unsigned)__builtin_amdgcn_s_getreg((3 << 11) | 20) & 0xFu; }
#define XB_SPIN(cond, bar) do { unsigned _sp = 0; while (cond) { __builtin_amdgcn_s_sleep(1); \
    if ((++_sp & 255u) == 0u) { if (xb_ld(&(bar)[XB_TMO])) break; if (_sp > XB_SPIN_CAP) { atomicAdd(&(bar)[XB_TMO], 1u); break; } } } } while (0)

struct XcdBarrier {
    unsigned* bar; unsigned x;
    volatile LAS unsigned* st;
};

__device__ __forceinline__ XcdBarrier xcd_barrier_post(unsigned* bar, volatile LAS unsigned* st) {
    XcdBarrier b; b.bar = bar; b.x = xb_xcc_id(); b.st = st;
    if (threadIdx.x == 0) (void)xb_add(&bar[XB_XCNT(b.x)], 1u);
    return b;
}
__device__ __forceinline__ void xcd_barrier_complete(unsigned* bar, unsigned x, unsigned& nloc, unsigned& nx) {
    const unsigned G = gridDim.x * gridDim.y * gridDim.z;
    unsigned sum, cnt, mine, sp = 0u;
    for (;;) {
        sum = 0u; cnt = 0u; mine = 0u;
#pragma unroll
        for (unsigned j = 0; j < 16; ++j) { const unsigned c = xb_ld(&bar[XB_XCNT(j)]); sum += c; cnt += (c > 0u) ? 1u : 0u; mine = (j == x) ? c : mine; }
        if (sum == G) break;
        __builtin_amdgcn_s_sleep(1);
        if ((++sp & 255u) == 0u) { if (xb_ld(&bar[XB_TMO])) break; if (sp > XB_SPIN_CAP) { atomicAdd(&bar[XB_TMO], 1u); break; } }
    }
    nloc = mine > 0u ? mine : 1u; nx = cnt > 0u ? cnt : 1u;
}

__device__ __forceinline__ void xcd_barrier(const XcdBarrier& b) {
    asm volatile("s_waitcnt vmcnt(0)" ::: "memory");
    __syncthreads();
    if (threadIdx.x == 0) {
        unsigned* bar = b.bar;
        __builtin_amdgcn_s_waitcnt(0);
        unsigned nloc = b.st[0], nx = b.st[1];
        if (nloc == 0u) { xcd_barrier_complete(bar, b.x, nloc, nx); b.st[0] = nloc; b.st[1] = nx; }
        const unsigned old = xb_add(&bar[XB_XSUB(b.x)], 1u);
        const unsigned gen = old / nloc;
        if (old + 1u == (gen + 1u) * nloc) {
            __builtin_amdgcn_fence(__ATOMIC_RELEASE, "agent");
            asm volatile("s_waitcnt vmcnt(0)" ::: "memory");
            const unsigned og = xb_add(&bar[XB_TOP], 1u);
            const unsigned tg = og / nx;
            if (og + 1u == (tg + 1u) * nx) xb_add(&bar[XB_TOPGEN], 1u);
            else XB_SPIN(xb_ld(&bar[XB_TOPGEN]) == tg, bar);
            __builtin_amdgcn_fence(__ATOMIC_ACQUIRE, "agent");
            xb_add(&bar[XB_XGEN(b.x)], 1u);
            asm volatile("s_waitcnt vmcnt(0)" ::: "memory");
        } else {
            XB_SPIN(xb_ld(&bar[XB_XGEN(b.x)]) == gen, bar);
            __builtin_amdgcn_fence(__ATOMIC_ACQUIRE, "agent");
            asm volatile("s_waitcnt vmcnt(0)" ::: "memory");
        }
    }
    __syncthreads();
}

__global__ void __launch_bounds__(512) mega_fwd(Args args) {
    extern __shared__ __attribute__((aligned(16))) unsigned char lds_raw[];
    LAS unsigned char* lds = (LAS unsigned char*)lds_raw;
    const int ph_lo = args.ph_lo, ph_hi = args.ph_hi;
    volatile LAS unsigned* bst = (volatile LAS unsigned*)(lds + 147456 + 64);
    if (threadIdx.x == 0) { bst[0] = 0u; bst[1] = 0u; }
    __syncthreads();
    if (ph_hi - ph_lo > 1) (void)xcd_barrier_post((unsigned*)(args.ws + WS_BAR), bst);

    constexpr int I_AB = 32 * (AB_IN / 32), I_C = 32 * (C_IN / 32), I_O = 32 * (DM / 32);
#define TR_LAYER(Lx, gwi, nwi) do { const int l2_ = (Lx) >> 1; LAS float* scr_ = (LAS float*)(lds + wave * 16384); \
        if ((Lx) & 1) { for (int it_ = (gwi); it_ < I_C + I_O; it_ += (nwi)) { \
            if (it_ < I_C) p0_transpose_item(ap->in[12] + (size_t)l2_ * DM * C_IN, ap->in[11] + l2_ * DM, DM, C_IN, (u16*)(ws + WS_WIN_C) + (size_t)l2_ * C_IN * DM, scr_, it_, lane); \
            else p0_transpose_item(ap->in[13] + (size_t)l2_ * DM * DM, nullptr, DM, DM, (u16*)(ws + WS_WOUT_C) + (size_t)l2_ * DM * DM, scr_, it_ - I_C, lane); } } \
        else { for (int it_ = (gwi); it_ < I_AB + I_O; it_ += (nwi)) { \
            if (it_ < I_AB) p0_transpose_item(ap->in[3] + (size_t)l2_ * DM * AB_IN, ap->in[2] + l2_ * DM, DM, AB_IN, (u16*)(ws + WS_WIN_AB) + (size_t)l2_ * AB_IN * DM, scr_, it_, lane); \
            else p0_transpose_item(ap->in[4] + (size_t)l2_ * DM * DM, nullptr, DM, DM, (u16*)(ws + WS_WOUT_AB) + (size_t)l2_ * DM * DM, scr_, it_ - I_AB, lane); } } } while (0)
#ifndef PROBE_SUB
#define PROBE_SUB -1
#endif
#ifndef PROBE_PAR
#define PROBE_PAR 2
#endif
    for (int ph = ph_lo; ph < ph_hi; ++ph) {
      const int nrep = (PROBE_SUB >= 0 && ph > 0 && (ph - 1) % 4 == PROBE_SUB && (PROBE_PAR == 2 || (((ph - 1) / 4) & 1) == PROBE_PAR)) ? 2 : ((PROBE_SUB == -2 && ph == 0) ? 2 : 1);
      for (int rep = 0; rep < nrep; ++rep) {
        typedef const __attribute__((address_space(4))) Args* kargs_t;
        kargs_t ap; { auto k = __builtin_amdgcn_kernarg_segment_ptr(); asm volatile("" : "+s"(k)); ap = (kargs_t)k; }
        int tid = threadIdx.x, G = gridDim.x, c = blockIdx.x; asm volatile("" : "+v"(tid), "+s"(G), "+s"(c));
        const int lane = tid & 63, wave = __builtin_amdgcn_readfirstlane(tid >> 6), gw = c * 8 + wave, ngw = G * 8;
        unsigned char* ws = ap->ws; float* out = ap->out;
        u16* H = (u16*)(ws + WS_H); u16* Y = (u16*)(ws + WS_Y); u16* Z = (u16*)(ws + WS_Z); u16* KV = (u16*)(ws + WS_KV); float* SSQ = (float*)(ws + WS_SSQ);
        const float* xs_off = ap->in[1] - (size_t)NTOK_P * DM;
        if (ph == 0) {
            TR_LAYER(0, gw, ngw);
            rope_tables(ws, c * 512 + tid, G * 512);
            for (int e = c * 512 + tid; e < 3 * MTOK; e += G * 512) SSQ[MTOK + e] = 0.f;
            cvt_phase(ap->in[0], xs_off, H, SSQ, gw, ngw, lane);
        } else {
            const int L = (ph - 1) / 4, sub = (ph - 1) % 4, li = L >> 1; const bool odd = (L & 1) != 0;
            if (sub == 0) {
#ifndef NO_GEMM_IN
                LAS float* rst = (LAS float*)(lds + 131072);
#define RST_FILL() do { const float* ssq_ = SSQ + L * MTOK; for (int i_ = 0; i_ < 16; ++i_) { pg8::Unit u_; if (!S.next(i_, u_)) break; \
                    if (tid < 256) rst[i_ * 256 + tid] = 1.0f / sqrtf(ssq_[u_.pm * 256 + tid] * (1.f / DM) + EPS); } __syncthreads(); } while (0)
                if (!odd) { pg8::Gemm g{H, (const u16*)(ws + WS_WIN_AB) + (size_t)li * AB_IN * DM, MTOK, AB_IN, DM}; pg8::StaticOrder S; S.init(MTOK, AB_IN, G, c);
                    RST_FILL(); pg8::EpiAct E{Z, AB_IN, 2048, 3072, 4608, KV, 4096, 4608, rst}; pg8::gemm_phase<pg8::EpiAct, pg8::StaticOrder, true, true>(lds, g, S, E); }
                else { pg8::Gemm g{H, (const u16*)(ws + WS_WIN_C) + (size_t)li * C_IN * DM, MTOK, C_IN, DM}; pg8::StaticOrder S; S.init(MTOK, C_IN, G, c);
                    RST_FILL(); pg8::EpiAct E{Z, C_IN, 0, 0, 3072, KV, 2048, 3072, rst}; pg8::gemm_phase<pg8::EpiAct, pg8::StaticOrder, true, true>(lds, g, S, E); }
                if (L < 3) { const int nwg_ = (MTOK / 256) * ((odd ? C_IN : AB_IN) / 256), nr_ = (nwg_ + G - 1) / G; int c0_ = nwg_ - (nr_ - 1) * G; if (c0_ >= G) c0_ = 0;
                    if (c >= c0_) TR_LAYER(L + 1, (c - c0_) * 8 + wave, (G - c0_) * 8); }
#endif
            } else if (sub == 1) {
                if (!odd) prep_phase<false>(KV, ap->in[9] + li * 128, ws, gw, ngw, lane);
                else prep_phase<true>(KV, ap->in[15] + li * 128, ws, gw, ngw, lane);
            } else if (sub == 2) {
                if (!odd) {
#ifndef NO_MIXB
                    {
                    const int vcb = (G % 8 == 0) ? (c & 7) * (G / 8) + (c >> 3) : c;
                    for (int ub = vcb; ub < (MTOK / 128) * 4; ub += G) {
                        const int blk = ub >> 2, h0 = (ub & 3) * 2, kvh = h0 >> 2; int seq0, S_, i0;
                        if (blk < NTOK_P / 128) { seq0 = (blk / (SEQ_P / 128)) * SEQ_P; S_ = SEQ_P; i0 = (blk % (SEQ_P / 128)) * 128; }
                        else { const int r2 = blk - NTOK_P / 128; seq0 = NTOK_P + (r2 / (SEQ_S / 128)) * SEQ_S; S_ = SEQ_S; i0 = (r2 % (SEQ_S / 128)) * 128; }
                        const int k_lo = i0 >= 128 ? i0 - 128 : 0, k_hi = (i0 + 256 <= S_) ? i0 + 256 : S_, NT = (k_hi - k_lo) >> 6;
                        const u16* zq = Z + (size_t)(seq0 + i0) * AB_IN; const u16* kvp = KV + (size_t)(seq0 + k_lo) * 128;
                        const int un = ub + G; const bool hn = un < (MTOK / 128) * 4;
                        const u16* qnext = hn ? Z + (size_t)((un >> 2) * 128) * AB_IN + 3072 + ((un & 3) * 2) * 128 : nullptr;
                        att::attn_unit<true, AB_IN, 2>(zq + 3072 + h0 * 128, kvp + (size_t)kvh * MTOK * 128, kvp + (size_t)(2 + kvh) * MTOK * 128, zq + 4608 + h0 * 128,
                                                    Y + (size_t)(seq0 + i0) * DM + 1024 + h0 * 128, NT, ap->in[10] + li * 8 + h0, i0 - k_lo, (LAS char*)lds,
                                                    ap->in[8] + li * 128, (const f32x2*)(ws + WS_TABB), (const f32x2*)(ws + WS_TABB), i0);
                        __syncthreads();
                    } }
#endif
#ifndef NO_MIXA
                    mixer_a_phase(Z, Y, ap->in[5] + li * 1024, ap->in[6] + (size_t)li * 8 * 128 * 128, ap->in[7] + li * 1024, c, G, (LAS char*)lds);
#endif
                } else {
#ifndef NO_MIXC
                    const int nun = (G == 256) ? 10 : (2560 + G - 1) / G;
#define MC_UNIT(i_, ok_, b_, h_, qb_, samp_) do { ok_ = true; \
                        if (G == 256) { const int x_ = c & 7, l_ = c >> 3; \
                            if ((i_) < 8) { const int pair_ = 2 * x_ + ((i_) >> 2); b_ = pair_ >> 2; h_ = (pair_ & 3) * 4 + ((i_) & 3); qb_ = l_; samp_ = false; } \
                            else { const int pair_ = 2 * x_ + ((i_) - 8); b_ = pair_ >> 2; h_ = (pair_ & 3) * 4 + (l_ >> 3); qb_ = l_ & 7; samp_ = true; } \
                            if ((i_) >= 10) ok_ = false; \
                        } else { const int u_ = c + (i_) * G; if (u_ >= 2560) ok_ = false; \
                            if (u_ < 2048) { b_ = u_ >> 9; h_ = (u_ >> 5) & 15; qb_ = u_ & 31; samp_ = false; } else { const int v_ = u_ - 2048; b_ = v_ >> 7; h_ = (v_ >> 3) & 15; qb_ = v_ & 7; samp_ = true; } } } while (0)
                    {
                    for (int i = 0; i < nun; ++i) {
                        int b, h, qb; bool samp, ok; MC_UNIT(i, ok, b, h, qb, samp); if (!ok) break;
                        const int seq0 = samp ? NTOK_P + b * SEQ_S : b * SEQ_P, S_ = samp ? SEQ_S : SEQ_P, i0 = qb * 256;
                        const u16* zq = Z + (size_t)(seq0 + i0) * C_IN; const u16* kvp = KV + (size_t)seq0 * 128;
                        int bn, hn_, qbn; bool sampn, okn; MC_UNIT(i + 1, okn, bn, hn_, qbn, sampn); okn = okn && (i + 1 < nun);
                        const u16* qnext = okn ? Z + (size_t)((sampn ? NTOK_P + bn * SEQ_S : bn * SEQ_P) + qbn * 256) * C_IN + hn_ * 128 : nullptr;
                        att::attn_unit<false, C_IN, 2>(zq + h * 128, kvp + (size_t)(h >> 2) * MTOK * 128, kvp + (size_t)(4 + (h >> 2)) * MTOK * 128, zq + 3072 + h * 128,
                                                    Y + (size_t)(seq0 + i0) * DM + h * 128, S_ >> 6, nullptr, 0, (LAS char*)lds,
                                                    ap->in[14] + li * 128, (const f32x2*)(ws + WS_TABR), (const f32x2*)(ws + WS_TABC), i0);
                        __syncthreads();
                    } }
#undef MC_UNIT
#endif
                }
            } else {
#ifndef NO_GEMM_OUT
                const u16* wt = odd ? (const u16*)(ws + WS_WOUT_C) + (size_t)li * DM * DM : (const u16*)(ws + WS_WOUT_AB) + (size_t)li * DM * DM;
                pg8::Gemm g{Y, wt, MTOK, DM, DM}; pg8::StaticOrder S; S.init(MTOK, DM, G, c);
                pg8::EpiRes E{L == 0 ? ap->in[0] : nullptr, L == 0 ? xs_off : nullptr, H, L == 3 ? out : nullptr, DM, NTOK_P, L < 3 ? H : nullptr, SSQ + (L < 3 ? L + 1 : 0) * MTOK};
                pg8::gemm_phase<pg8::EpiRes, pg8::StaticOrder, true, true>(lds, g, S, E);
#endif
            }
        }
        if (ph + 1 < ph_hi || rep + 1 < nrep) {
            if (ph == ph_lo && rep == 0) cg::this_grid().sync();
            else { XcdBarrier xb; xb.bar = (unsigned*)(ap->ws + WS_BAR); xb.x = xb_xcc_id(); xb.st = bst; xcd_barrier(xb); }
        }
      }
    }
}

extern "C" void kernel_launch(void* const* d_in, const int* in_sizes, int n_in, void* d_out, int out_size, void* d_ws, size_t ws_size, hipStream_t stream) {
    static int grid = 0;
    if (grid == 0) {
        if (n_in != 16 || out_size != MTOK * DM || ws_size < WS_END) { fprintf(stderr, "kernel_launch: unexpected shapes: n_in %d out %d ws %zu (need %zu)\n", n_in, out_size, ws_size, (size_t)WS_END); grid = -1; return; }
        int dev = 0, cus = 0, per_cu = 0;
        if (hipGetDevice(&dev) != hipSuccess || hipDeviceGetAttribute(&cus, hipDeviceAttributeMultiprocessorCount, dev) != hipSuccess) { fprintf(stderr, "kernel_launch: device query failed\n"); grid = -1; return; }
        if (hipFuncSetAttribute((const void*)mega_fwd, hipFuncAttributeMaxDynamicSharedMemorySize, LDS_BYTES) != hipSuccess) { fprintf(stderr, "kernel_launch: hipFuncSetAttribute failed\n"); grid = -1; return; }
        if (hipOccupancyMaxActiveBlocksPerMultiprocessor(&per_cu, (const void*)mega_fwd, 512, LDS_BYTES) != hipSuccess || per_cu < 1) { fprintf(stderr, "kernel_launch: occupancy query gave %d\n", per_cu); (void)hipGetLastError(); per_cu = 1; }
        if (cus * 16 < (MTOK / 256) * (AB_IN / 256)) { fprintf(stderr, "kernel_launch: %d CUs: the in-projection phase would give a workgroup more than 16 units (its LDS table of row scales holds 16)\n", cus); grid = -1; return; }
        grid = cus * 1;
    }
    if (grid < 0) return;
    if (hipMemsetAsync((char*)d_ws + WS_BAR, 0, BAR_BYTES, stream) != hipSuccess) { fprintf(stderr, "kernel_launch: memset of the barrier words failed\n"); return; }
    Args a{};
    for (int i = 0; i < 16; ++i) a.in[i] = (const float*)d_in[i];
    a.out = (float*)d_out; a.ws = (unsigned char*)d_ws;
#if MK_MULTI
    for (int ph = 0; ph < NPHASE; ++ph) { a.ph_lo = ph; a.ph_hi = ph + 1;
        hipLaunchKernelGGL(mega_fwd, dim3(grid), dim3(512), LDS_BYTES, stream, a);
        const hipError_t le = hipPeekAtLastError(); if (le != hipSuccess) { fprintf(stderr, "kernel_launch: launch %d failed: %s\n", ph, hipGetErrorName(le)); break; } }
#else
    a.ph_lo = 0; a.ph_hi = NPHASE;
    void* kargs[] = {&a};
    const hipError_t le = hipLaunchCooperativeKernel((const void*)mega_fwd, dim3(grid), dim3(512), kargs, LDS_BYTES, stream);
    if (le != hipSuccess) fprintf(stderr, "kernel_launch: cooperative launch failed: %s (grid %d)\n", hipGetErrorString(le), grid);
#endif
}
```
